# Optimizing an MI355X kernel written in HIP

```python
import jax, jax.numpy as jnp
from jax import lax
import numpy as np

D_MODEL = 2048
BATCH = 4
SEQ = 2048
DEPTH = 1

N_META = 16
CHUNK = 64
MIX_WIDTH = D_MODEL
GLA_WIDTH = MIX_WIDTH // 2
POOL_WIDTH = MIX_WIDTH - GLA_WIDTH
GLA_HEADS = 4
GLA_DV = GLA_WIDTH // GLA_HEADS
GLA_DK = GLA_DV // 2
GLA_KW = GLA_HEADS * GLA_DK
GATE_RANK = 16
GATE_TAU = 16.0
POOL_WINDOWS = (2, 4, 8, 16)
POOL_GROUPS = len(POOL_WINDOWS)
POOL_GC = POOL_WIDTH // POOL_GROUPS
D_FF = 4 * D_MODEL
EPS = 1e-6
SPLIT_POINTS = (
    GLA_KW,
    2 * GLA_KW,
    2 * GLA_KW + GLA_WIDTH,
    2 * GLA_KW + 2 * GLA_WIDTH,
    2 * GLA_KW + 2 * GLA_WIDTH + GATE_RANK,
)
D_IN = 2 * GLA_KW + 2 * GLA_WIDTH + GATE_RANK + POOL_WIDTH

kernel_name = "hybrid_gla_multiscale_pool_meta"


def rmsnorm(x, w):
    xf = x.astype(jnp.float32)
    y = xf * lax.rsqrt(jnp.mean(xf * xf, axis=-1, keepdims=True) + EPS)
    return (y * w.astype(jnp.float32)).astype(x.dtype)


def gla_chunked(q, k, v, logg):
    B, T, H, DK = q.shape
    DV = v.shape[-1]
    N = T // CHUNK

    def chunks(a):
        return a.reshape(B, N, CHUNK, H, a.shape[-1]).transpose(0, 3, 1, 2, 4)

    q, k, v, logg = chunks(q), chunks(k), chunks(v), chunks(logg)
    G = jnp.cumsum(logg, axis=3)
    G_last = G[:, :, :, -1:, :]
    q_dec = q * jnp.exp(G)
    k_inv = k * jnp.exp(-G)
    causal = jnp.tril(jnp.ones((CHUNK, CHUNK), dtype=bool))
    scores = jnp.einsum('bhncd,bhnsd->bhncs', q_dec, k_inv)
    scores = jnp.where(causal, scores, 0.0)
    o_intra = jnp.einsum('bhncs,bhnsv->bhncv', scores, v)
    k_to_end = k * jnp.exp(G_last - G)
    dS = jnp.einsum('bhncd,bhncv->bhndv', k_to_end, v)
    decay = jnp.exp(G_last[:, :, :, 0, :])

    def step(S, inp):
        dec, ds = inp
        return dec[..., None] * S + ds, S

    S0 = jnp.zeros((B, H, DK, DV), jnp.float32)
    _, S_prev = lax.scan(step, S0, (decay.transpose(2, 0, 1, 3), dS.transpose(2, 0, 1, 3, 4)))
    S_prev = S_prev.transpose(1, 2, 0, 3, 4)
    o_inter = jnp.einsum('bhncd,bhndv->bhncv', q_dec, S_prev)
    o = o_intra + o_inter
    return o.transpose(0, 2, 3, 1, 4).reshape(B, T, H, DV)


def multiscale_pool(pu, pool_w, pool_scale):
    B, L, _ = pu.shape
    xg = pu.astype(jnp.float32).reshape(B, L, POOL_GROUPS, POOL_GC)
    cs = jnp.pad(jnp.cumsum(xg, axis=1), ((0, 0), (1, 0), (0, 0), (0, 0)))
    t = jnp.arange(L)
    win = jnp.array(POOL_WINDOWS, dtype=jnp.int32)
    lo = jnp.maximum(t[:, None] + 1 - win[None, :], 0)
    g_idx = jnp.arange(POOL_GROUPS)[None, :]
    window_sum = cs[:, 1:] - cs[:, lo, g_idx]
    count = (t[:, None] + 1 - lo).astype(jnp.float32)[None, :, :, None]
    y = window_sum / count - xg
    y = jnp.einsum('blgc,gcd->blgd', y, pool_w.astype(jnp.float32))
    return y.reshape(B, L, POOL_WIDTH) * pool_scale.astype(jnp.float32)


def hybrid_layer(h, norm1_w, w_in, gate_w2, gate_b, gla_norm_w, pool_w, pool_scale,
                 w_out, norm2_w, mlp_w1, mlp_w2):
    B, L, _ = h.shape
    u = rmsnorm(h, norm1_w)
    proj = u @ w_in
    q, k, v, r, glr, pu = jnp.split(proj, SPLIT_POINTS, axis=-1)

    g_raw = (glr @ gate_w2 + gate_b).astype(jnp.float32)
    logg = jax.nn.log_sigmoid(g_raw) / GATE_TAU
    pad = (-N_META) % CHUNK

    def heads(a, d):
        a = a.astype(jnp.float32).reshape(B, L, GLA_HEADS, d)
        return jnp.pad(a, ((0, 0), (pad, 0), (0, 0), (0, 0)))

    o = gla_chunked(heads(q, GLA_DK) * (GLA_DK ** -0.5), heads(k, GLA_DK),
                    heads(v, GLA_DV), heads(logg, GLA_DK))[:, pad:]
    o = rmsnorm(o, gla_norm_w)
    gate_out = jax.nn.silu(r.astype(jnp.float32)).reshape(B, L, GLA_HEADS, GLA_DV)
    o_gla = (o * gate_out).reshape(B, L, GLA_WIDTH)

    o_pool = multiscale_pool(pu, pool_w, pool_scale)

    mixed = jnp.concatenate([o_gla, o_pool], axis=-1).astype(h.dtype)
    h = h + mixed @ w_out

    z = rmsnorm(h, norm2_w) @ mlp_w1
    h = h + jnp.square(jax.nn.relu(z)) @ mlp_w2
    return h


def setup_inputs(seed: int = 0) -> dict:
    key = jax.random.key(seed)
    ks = jax.random.split(key, 16)
    f32 = jnp.float32
    nrm = lambda k, shape, s: jax.random.normal(k, shape, f32) * s
    return {
        "x": nrm(ks[0], (BATCH, SEQ, D_MODEL), 1.0),
        "meta_tokens": nrm(ks[1], (N_META, D_MODEL), 1.0),
        "norm1_w": 1.0 + nrm(ks[2], (DEPTH, D_MODEL), 0.02),
        "w_in": nrm(ks[3], (DEPTH, D_MODEL, D_IN), D_MODEL ** -0.5),
        "gate_w2": nrm(ks[4], (DEPTH, GATE_RANK, GLA_KW), GATE_RANK ** -0.5),
        "gate_b": nrm(ks[5], (DEPTH, GLA_KW), 0.1),
        "gla_norm_w": 1.0 + nrm(ks[6], (DEPTH, GLA_DV), 0.02),
        "pool_w": nrm(ks[7], (DEPTH, POOL_GROUPS, POOL_GC, POOL_GC), POOL_GC ** -0.5),
        "pool_scale": 1.0 + nrm(ks[8], (DEPTH, POOL_WIDTH), 0.1),
        "w_out": nrm(ks[9], (DEPTH, MIX_WIDTH, D_MODEL), MIX_WIDTH ** -0.5),
        "norm2_w": 1.0 + nrm(ks[10], (DEPTH, D_MODEL), 0.02),
        "mlp_w1": nrm(ks[11], (DEPTH, D_MODEL, D_FF), D_MODEL ** -0.5),
        "mlp_w2": nrm(ks[12], (DEPTH, D_FF, D_MODEL), D_FF ** -0.5),
        "final_norm_w": 1.0 + nrm(ks[13], (D_MODEL,), 0.02),
    }


def reference(x, meta_tokens, norm1_w, w_in, gate_w2, gate_b, gla_norm_w, pool_w,
              pool_scale, w_out, norm2_w, mlp_w1, mlp_w2, final_norm_w):
    B = x.shape[0]
    meta = jnp.broadcast_to(meta_tokens[None].astype(x.dtype), (B, N_META, D_MODEL))
    h = jnp.concatenate([meta, x], axis=1)
    for i in range(DEPTH):
        h = hybrid_layer(h, norm1_w[i], w_in[i], gate_w2[i], gate_b[i], gla_norm_w[i],
                         pool_w[i], pool_scale[i], w_out[i], norm2_w[i], mlp_w1[i], mlp_w2[i])
    h = rmsnorm(h, final_norm_w)
    return h[:, N_META:]
```

```cpp
#include <hip/hip_runtime.h>
#include <hip/hip_cooperative_groups.h>
#include <cstdio>
namespace cg = cooperative_groups;
#ifndef REP_SYNC
#define REP_SYNC 1
#endif
#ifndef REP_P0
#define REP_P0 1
#endif
#ifndef REP_P1
#define REP_P1 1
#endif
#ifndef REP_P2BC
#define REP_P2BC 1
#endif
#ifndef REP_P3
#define REP_P3 1
#endif
#ifndef REP_P4
#define REP_P4 1
#endif
#ifndef PROBE_STOP
#define PROBE_STOP 0
#endif
#ifndef PROBE_VAR
#define PROBE_VAR 0
#endif
#define GSYNC() do { for (int _r = 0; _r < REP_SYNC; ++_r) xcd_barrier(xb); } while (0)
#define STOP_AT(k) do { if (PROBE_STOP && p.stop == (k)) return; } while (0)

#define LAS __attribute__((address_space(3)))
typedef unsigned short bf16_t;
typedef short bf16x8 __attribute__((ext_vector_type(8)));
typedef float f32x4 __attribute__((ext_vector_type(4)));
typedef unsigned u32x4 __attribute__((ext_vector_type(4)));
typedef unsigned u32x2 __attribute__((ext_vector_type(2)));

constexpr int DM = 2048, MR = 8192  , NMETA = 16, MA = MR + NMETA, DIN = 4112, NPROJ = 4096, PLD = 4160  , XLD = 2112  , DFF = 8192;
constexpr float EPS = 1e-6f;
constexpr int NBLK = 256, NTHR = 512;
constexpr int LDS_BYTES = 139264;

constexpr size_t SLOT = 33554432ull;
constexpr size_t OFF_WINT = 0;
constexpr size_t OFF_XB = 17369088;
constexpr size_t OFF_MIXED = 0;
constexpr size_t OFF_PROJ = 52039680;
constexpr size_t OFF_GLR = 120330240;
constexpr size_t OFF_DECAY = 120855552;
constexpr size_t OFF_DSMETA = 121119744;
constexpr size_t OFF_WOUTT = 123216896;
constexpr size_t OFF_POOLWT = 131605504;
constexpr size_t OFF_ACT = 0;
constexpr size_t OFF_W1T = 4 * SLOT;
constexpr size_t OFF_W2T = 5 * SLOT;
constexpr size_t OFF_OINTRA = 6 * SLOT;
constexpr size_t OFF_H2B = 6 * SLOT;
constexpr size_t OFF_SMETAB = 132129792;
constexpr size_t OFF_SPREV = 7 * SLOT;
constexpr size_t OFF_SS2P = 7 * SLOT + 32505856;
constexpr size_t OFF_SS3P = OFF_SS2P + 262144;
constexpr size_t OFF_BAR = OFF_SS3P + 262144;
constexpr size_t OFF_PCNT = OFF_BAR + 16384;
constexpr size_t WS_NEED = 8 * SLOT;

struct Params {
    const float *x, *meta, *norm1_w, *w_in, *gate_w2, *gate_b, *gla_norm_w, *pool_w, *pool_scale, *w_out, *norm2_w, *mlp_w1, *mlp_w2, *final_norm_w;
    float* out; unsigned char* ws; int stop; int pad;
};

typedef __bf16 hwbf16x2 __attribute__((ext_vector_type(2)));
typedef float f32x2v __attribute__((ext_vector_type(2)));
__device__ __forceinline__ unsigned cvt_pk_bf16(float lo, float hi) { const f32x2v f = {lo, hi}; const hwbf16x2 v = __builtin_convertvector(f, hwbf16x2); return __builtin_bit_cast(unsigned, v); }
__device__ __forceinline__ float bf2f(bf16_t u) { return __uint_as_float(((unsigned)u) << 16); }
__device__ __forceinline__ bf16_t f2bf(float f) { unsigned u = __float_as_uint(f); u += 0x7FFFu + ((u >> 16) & 1u); return (bf16_t)(u >> 16); }
__device__ __forceinline__ float wave_sum(float v) {
#pragma unroll
    for (int o = 1; o < 64; o <<= 1) v += __shfl_xor(v, o);
    return v;
}
__device__ __forceinline__ void lds_barrier() { asm volatile("s_waitcnt lgkmcnt(0)" ::: "memory"); __builtin_amdgcn_s_barrier(); asm volatile("" ::: "memory"); }
__device__ __forceinline__ int opaque_tid() { int t = threadIdx.x; asm volatile("" : "+v"(t)); return t; }
__device__ __forceinline__ f32x4 mfma16(bf16x8 a, bf16x8 b, f32x4 c) { return __builtin_amdgcn_mfma_f32_16x16x32_bf16(a, b, c, 0, 0, 0); }


#define XB_TMO      128
#define XB_XCNT(j)  (256  + 64 * (j))
#define XB_XSUB(j)  (1280 + 64 * (j))
#define XB_XGEN(j)  (2304 + 64 * (j))
#define XB_TOP      3328
#define XB_TOPGEN   3392
#define XCD_BAR_WORDS 3456
#define XB_SPIN_CAP (1u << 22)
__device__ __forceinline__ unsigned xb_ld(unsigned* p)              { return __hip_atomic_load(p, __ATOMIC_RELAXED, __HIP_MEMORY_SCOPE_AGENT); }
__device__ __forceinline__ unsigned xb_add(unsigned* p, unsigned v) { return __hip_atomic_fetch_add(p, v, __ATOMIC_RELAXED, __HIP_MEMORY_SCOPE_AGENT); }
__device__ __forceinline__ unsigned xb_xcc_id() { return (unsigned)__builtin_amdgcn_s_getreg((3 << 11) | 20) & 0xFu; }
#define XB_SPIN(cond, bar) do { unsigned _sp = 0; while (cond) { __builtin_amdgcn_s_sleep(1); \
    if ((++_sp & 255u) == 0u) { if (xb_ld(&(bar)[XB_TMO])) break; if (_sp > XB_SPIN_CAP) { atomicAdd(&(bar)[XB_TMO], 1u); break; } } } } while (0)
struct XcdBarrier { unsigned* bar; unsigned x; volatile LAS unsigned* st; };
__device__ __forceinline__ XcdBarrier xcd_barrier_post(unsigned* bar, volatile LAS unsigned* st) {
    XcdBarrier b; b.bar = bar; b.x = xb_xcc_id(); b.st = st;
    if (threadIdx.x == 0) (void)xb_add(&bar[XB_XCNT(b.x)], 1u);
    return b;
}
__device__ __forceinline__ void xcd_barrier_complete(unsigned* bar, unsigned x, unsigned& nloc, unsigned& nx) {
    const unsigned G = gridDim.x * gridDim.y * gridDim.z;
    unsigned sum, cnt, mine, sp = 0u;
    for (;;) {
        sum = 0u; cnt = 0u; mine = 0u;
#pragma unroll
        for (unsigned j = 0; j < 16; ++j) { const unsigned c = xb_ld(&bar[XB_XCNT(j)]); sum += c; cnt += (c > 0u) ? 1u : 0u; mine = (j == x) ? c : mine; }
        if (sum == G) break;
        __builtin_amdgcn_s_sleep(1);
        if ((++sp & 255u) == 0u) { if (xb_ld(&bar[XB_TMO])) break; if (sp > XB_SPIN_CAP) { atomicAdd(&bar[XB_TMO], 1u); break; } }
    }
    nloc = mine > 0u ? mine : 1u; nx = cnt > 0u ? cnt : 1u;
}
__device__ __forceinline__ void xcd_barrier(const XcdBarrier& b) {
    asm volatile("s_waitcnt vmcnt(0)" ::: "memory");
    __syncthreads();
    if (threadIdx.x == 0) {
        unsigned* bar = b.bar;
        __builtin_amdgcn_s_waitcnt(0);
        unsigned nloc = b.st[0], nx = b.st[1];
        if (nloc == 0u) { xcd_barrier_complete(bar, b.x, nloc, nx); b.st[0] = nloc; b.st[1] = nx; }
        const unsigned old = xb_add(&bar[XB_XSUB(b.x)], 1u);
        const unsigned gen = old / nloc;
        if (old + 1u == (gen + 1u) * nloc) {
            __builtin_amdgcn_fence(__ATOMIC_RELEASE, "agent");
            asm volatile("s_waitcnt vmcnt(0)" ::: "memory");
            const unsigned og = xb_add(&bar[XB_TOP], 1u);
            const unsigned tg = og / nx;
            if (og + 1u == (tg + 1u) * nx) xb_add(&bar[XB_TOPGEN], 1u);
            else XB_SPIN(xb_ld(&bar[XB_TOPGEN]) == tg, bar);
            __builtin_amdgcn_fence(__ATOMIC_ACQUIRE, "agent");
            xb_add(&bar[XB_XGEN(b.x)], 1u);
            asm volatile("s_waitcnt vmcnt(0)" ::: "memory");
        } else {
            XB_SPIN(xb_ld(&bar[XB_XGEN(b.x)]) == gen, bar);
            __builtin_amdgcn_fence(__ATOMIC_ACQUIRE, "agent");
            asm volatile("s_waitcnt vmcnt(0)" ::: "memory");
        }
    }
    __syncthreads();
}

namespace pg8 {
constexpr int BM = 256, BK = 64, HALF = 128, HTB = HALF * BK * 2, STAGE_BYTES = 8 * HTB, NXCD = 8, WGM = 4;
__device__ __forceinline__ int lds_byte(int r, int c) { const int st = (r >> 4) * 2 + (c >> 5), rr = r & 15, cc = c & 31, ob = rr * 64 + cc * 2; return st * 1024 + (ob ^ (((ob >> 9) & 1) << 5)); }
__device__ __forceinline__ void stage_rc(int b, int& R, int& C) { const int st = b / 1024, sb = b % 1024, swz = sb ^ (((sb >> 9) & 1) << 5); R = (st >> 1) * 16 + swz / 64; C = (st & 1) * 32 + (swz % 64) / 2; }
__device__ __forceinline__ int perm32(int rho) { const int n = rho >> 4, i = rho & 15; return 8 * (i >> 2) + 4 * n + (i & 3); }

struct Unit { int pm, pn; };
struct Gemm { const bf16_t* A; const bf16_t* Bt; int M, N, K, lda, ldb; };

struct StaticOrder {
    int nM, nN, nwg, G, c, rev;
    __device__ void init(int M, int N, int G_, int c_, int rev_ = 0) { nM = M / BM; nN = N / BM; nwg = nM * nN; G = G_; c = c_; rev = rev_; }
    __device__ bool next(int i, Unit& u) const {
        const int nr = (nwg + G - 1) / G; if (i >= nr) return false;
        const long L = (long)(rev ? nr - 1 - i : i) * G + c; if (L >= nwg) return false;
        int wgid = (int)L; { const int q = nwg / NXCD, r = nwg % NXCD, xcd = wgid % NXCD, off = wgid / NXCD; wgid = (xcd < r ? xcd * (q + 1) : r * (q + 1) + (xcd - r) * q) + off; }
        const int nig = WGM * nN, gid = wgid / nig, fm = gid * WGM, gsz = (nM - fm) < WGM ? (nM - fm) : WGM;
        u.pm = fm + ((wgid % nig) % gsz); u.pn = (wgid % nig) / gsz; return true;
    }
};


template <class Epi>
__device__ __forceinline__ void gemm_phase(LAS unsigned char* lds, const Gemm g, const StaticOrder& S, const Epi& E) {
    const int tid = opaque_tid(), wid = __builtin_amdgcn_readfirstlane(tid >> 6), lane = tid & 63, wr = wid >> 2, wc = wid & 3, fr = lane & 15, fq = lane >> 4;
    const int K = g.K, nt = K / BK;
    unsigned voffA[2], voffB[2];
#pragma unroll
    for (int i = 0; i < 2; ++i) { int R, C; stage_rc(tid * 16 + i * 8192, R, C); const int Rb = Epi::PERM ? ((R & ~31) + perm32(R & 31)) : R;
        voffA[i] = (unsigned)(R * g.lda + C) * 2u; voffB[i] = (unsigned)(Rb * g.ldb + C) * 2u; }
    const size_t kstep = (size_t)(BK * 2);
    const size_t hstepA = (size_t)HALF * g.lda * 2, hstepB = (size_t)HALF * g.ldb * 2;
    const size_t tstepA = 2 * hstepA, tstepB = 2 * hstepB;
    const unsigned ldsw = (unsigned)wid * 1024u;
    const int aoff = lds_byte(wr * 64 + fr, fq * 8), boff = lds_byte(wc * 32 + fr, fq * 8);
#define PG8_SA(b, h) (((b) * 2 + (h)) * HTB)
#define PG8_SB(b, h) ((4 + (b) * 2 + (h)) * HTB)
#define PG8_STAGE(bufoff, gbase, voff) do { _Pragma("unroll") for (int _i = 0; _i < 2; ++_i) \
        __builtin_amdgcn_global_load_lds((const unsigned*)((const char*)(gbase) + (voff)[_i]), (LAS unsigned*)(lds + (bufoff) + ldsw + _i * 8192), 16, 0, 0); } while (0)
#define PG8_LDA(dst, b, h) do { _Pragma("unroll") for (int m = 0; m < 4; ++m) _Pragma("unroll") for (int k = 0; k < 2; ++k) dst[m][k] = *(const LAS bf16x8*)(lds + PG8_SA(b, h) + aoff + m * 2048 + k * 1024); } while (0)
#define PG8_LDB(dst, b, h) do { _Pragma("unroll") for (int n = 0; n < 2; ++n) _Pragma("unroll") for (int k = 0; k < 2; ++k) dst[n][k] = *(const LAS bf16x8*)(lds + PG8_SB(b, h) + boff + n * 2048 + k * 1024); } while (0)
#define PG8_MMA(ai, bj, At, Bt) do { __builtin_amdgcn_s_setprio(1); _Pragma("unroll") for (int m = 0; m < 4; ++m) _Pragma("unroll") for (int n = 0; n < 2; ++n) _Pragma("unroll") for (int k = 0; k < 2; ++k) \
        acc[ai][bj][m][n] = __builtin_amdgcn_mfma_f32_16x16x32_bf16(Bt[n][k], At[m][k], acc[ai][bj][m][n], 0, 0, 0); __builtin_amdgcn_s_setprio(0); } while (0)
#define PG8_WAIT_V(n) asm volatile("s_waitcnt vmcnt(" #n ")" ::: "memory")
#define PG8_WAIT_L(n) asm volatile("s_waitcnt lgkmcnt(" #n ")" ::: "memory")
#define PG8_BAR __builtin_amdgcn_s_barrier()
#define PG8_SCHED __builtin_amdgcn_sched_barrier(0)
    Unit cur, nxt; int ui = 0;
    if (!S.next(0, cur)) return;
    f32x4 acc[2][2][4][2];
    if constexpr (Epi::INIT) E.init(acc, cur, wr, wc, fr, fq);
    else {
#pragma unroll
    for (int a = 0; a < 2; ++a)
#pragma unroll
        for (int b = 0; b < 2; ++b)
#pragma unroll
            for (int m = 0; m < 4; ++m)
#pragma unroll
                for (int n = 0; n < 2; ++n) acc[a][b][m][n] = (f32x4){0.f, 0.f, 0.f, 0.f};
    }
    bf16x8 At[4][2], B0[2][2], B1[2][2];
    const char* cA = (const char*)g.A + (size_t)cur.pm * tstepA; const char* cB = (const char*)g.Bt + (size_t)cur.pn * tstepB;
    PG8_STAGE(PG8_SB(0, 0), cB, voffB); PG8_STAGE(PG8_SA(0, 0), cA, voffA); PG8_STAGE(PG8_SB(0, 1), cB + hstepB, voffB); PG8_STAGE(PG8_SA(0, 1), cA + hstepA, voffA);
    if (wr == 1) PG8_BAR;
    PG8_WAIT_V(4); PG8_BAR;
    PG8_STAGE(PG8_SB(1, 0), cB + kstep, voffB); PG8_STAGE(PG8_SA(1, 0), cA + kstep, voffA); PG8_STAGE(PG8_SB(1, 1), cB + hstepB + kstep, voffB);
    PG8_WAIT_V(6); PG8_BAR;
    if constexpr (Epi::INIT) {
#pragma unroll
        for (int a = 0; a < 2; ++a)
#pragma unroll
            for (int b = 0; b < 2; ++b)
#pragma unroll
                for (int m = 0; m < 4; ++m) asm volatile("" : "+v"(acc[a][b][m][0]), "+v"(acc[a][b][m][1]));
    }
    for (;;) {
        const bool has_next = S.next(ui + 1, nxt);
        const char* nA = has_next ? (const char*)g.A + (size_t)nxt.pm * tstepA : cA; const char* nB = has_next ? (const char*)g.Bt + (size_t)nxt.pn * tstepB : cB;
        for (int t = 0; t < nt; t += 2) {
            const bool last = (t == nt - 2);
            const char* a1 = cA + (size_t)(t + 1) * kstep;
            const char* a2 = last ? nA : cA + (size_t)(t + 2) * kstep; const char* b2 = last ? nB : cB + (size_t)(t + 2) * kstep;
            const char* a3 = a2 + kstep; const char* b3 = b2 + kstep;
            PG8_LDB(B0, 0, 0); PG8_SCHED; PG8_LDA(At, 0, 0); PG8_STAGE(PG8_SA(1, 1), a1 + hstepA, voffA);
            PG8_WAIT_L(8); PG8_BAR; PG8_WAIT_L(0); PG8_MMA(0, 0, At, B0); PG8_BAR; PG8_SCHED;
            PG8_LDB(B1, 0, 1); PG8_STAGE(PG8_SB(0, 0), b2, voffB);
            PG8_BAR; PG8_WAIT_L(0); PG8_MMA(0, 1, At, B1); PG8_BAR;
            PG8_LDA(At, 0, 1); PG8_STAGE(PG8_SA(0, 0), a2, voffA);
            PG8_BAR; PG8_WAIT_L(0); PG8_MMA(1, 0, At, B0); PG8_BAR; PG8_SCHED;
            PG8_STAGE(PG8_SB(0, 1), b2 + hstepB, voffB);
            PG8_WAIT_V(6); PG8_BAR; PG8_MMA(1, 1, At, B1); PG8_BAR;
            PG8_LDB(B0, 1, 0); PG8_SCHED; PG8_LDA(At, 1, 0); PG8_STAGE(PG8_SA(0, 1), a2 + hstepA, voffA);
            PG8_WAIT_L(8); PG8_BAR; PG8_WAIT_L(0); PG8_MMA(0, 0, At, B0); PG8_BAR; PG8_SCHED;
            PG8_LDB(B1, 1, 1); PG8_STAGE(PG8_SB(1, 0), b3, voffB);
            PG8_BAR; PG8_WAIT_L(0); PG8_MMA(0, 1, At, B1); PG8_BAR;
            PG8_LDA(At, 1, 1); PG8_STAGE(PG8_SA(1, 0), a3, voffA);
            PG8_BAR; PG8_WAIT_L(0); PG8_MMA(1, 0, At, B0); PG8_BAR; PG8_SCHED;
            PG8_STAGE(PG8_SB(1, 1), b3 + hstepB, voffB);
            PG8_WAIT_V(6); PG8_BAR; PG8_MMA(1, 1, At, B1); PG8_BAR;
        }
        if constexpr (!Epi::AFTER_DRAIN) { E(acc, cur, ui, wr, wc, fr, fq); }
        if (!has_next) break;
#pragma unroll
        for (int a = 0; a < 2; ++a)
#pragma unroll
            for (int b = 0; b < 2; ++b)
#pragma unroll
                for (int m = 0; m < 4; ++m)
#pragma unroll
                    for (int n = 0; n < 2; ++n) acc[a][b][m][n] = (f32x4){0.f, 0.f, 0.f, 0.f};
        cur = nxt; cA = nA; cB = nB; ++ui;
    }
    PG8_WAIT_V(0);
    if (wr == 0) PG8_BAR;
    PG8_BAR;
    if constexpr (Epi::AFTER_DRAIN) { E.fused(acc, cur, wr, wc, fr, fq, lds, wid, lane); }
#undef PG8_SA
#undef PG8_SB
#undef PG8_STAGE
#undef PG8_LDA
#undef PG8_LDB
#undef PG8_MMA
#undef PG8_WAIT_V
#undef PG8_WAIT_L
#undef PG8_BAR
#undef PG8_SCHED
}

struct EpiBf16Scale {
    static constexpr bool PERM = true, AFTER_DRAIN = false, INIT = false;
    bf16_t* O; int ldc; const float* colscale;
    __device__ __forceinline__ void operator()(const f32x4 (&acc)[2][2][4][2], const Unit& u, int ui, int wr, int wc, int fr, int fq) const {
        const int row0 = u.pm * BM + wr * 64 + fr, col0 = u.pn * BM + wc * 32 + 8 * fq;
        f32x4 sv[2][2];
#pragma unroll
        for (int bj = 0; bj < 2; ++bj)
#pragma unroll
            for (int n = 0; n < 2; ++n) sv[bj][n] = colscale ? *(const f32x4*)(colscale + col0 + bj * HALF + 4 * n) : (f32x4){1.f, 1.f, 1.f, 1.f};
#pragma unroll
        for (int ai = 0; ai < 2; ++ai)
#pragma unroll
            for (int m = 0; m < 4; ++m) { bf16_t* rowp = O + (size_t)(row0 + ai * HALF + m * 16) * ldc + col0;
#pragma unroll
                for (int bj = 0; bj < 2; ++bj) { const f32x4 v0 = acc[ai][bj][m][0] * sv[bj][0], v1 = acc[ai][bj][m][1] * sv[bj][1];
                    u32x4 w; w.x = cvt_pk_bf16(v0[0], v0[1]); w.y = cvt_pk_bf16(v0[2], v0[3]); w.z = cvt_pk_bf16(v1[0], v1[1]); w.w = cvt_pk_bf16(v1[2], v1[3]);
                    *(u32x4*)(rowp + bj * HALF) = w; } }
    }
};
struct EpiSqRelu {
    static constexpr bool PERM = true, AFTER_DRAIN = false, INIT = false;
    bf16_t* O; int ldc; const LAS float* rl;
    __device__ __forceinline__ void operator()(const f32x4 (&acc)[2][2][4][2], const Unit& u, int ui, int wr, int wc, int fr, int fq) const {
        const int row0 = u.pm * BM + wr * 64 + fr, col0 = u.pn * BM + wc * 32 + 8 * fq;
#pragma unroll
        for (int ai = 0; ai < 2; ++ai)
#pragma unroll
            for (int m = 0; m < 4; ++m) { const int rloc = wr * 64 + fr + ai * HALF + m * 16; const int row = u.pm * BM + rloc;
                const float rstd = rl[ui * 256 + rloc];
                bf16_t* rowp = O + (size_t)row * ldc + col0;
#pragma unroll
                for (int bj = 0; bj < 2; ++bj) { f32x4 v0 = acc[ai][bj][m][0] * rstd, v1 = acc[ai][bj][m][1] * rstd;
#pragma unroll
                    for (int j = 0; j < 4; ++j) { const float a = fmaxf(v0[j], 0.f), b = fmaxf(v1[j], 0.f); v0[j] = a * a; v1[j] = b * b; }
                    u32x4 w; w.x = cvt_pk_bf16(v0[0], v0[1]); w.y = cvt_pk_bf16(v0[2], v0[3]); w.z = cvt_pk_bf16(v1[0], v1[1]); w.w = cvt_pk_bf16(v1[2], v1[3]);
                    *(u32x4*)(rowp + bj * HALF) = w; } }
    }
};
struct EpiResid {
    static constexpr bool PERM = false, AFTER_DRAIN = true, INIT = true;
    const float* base; float* out; bf16_t* outb; int ldc; float* ssp;
    __device__ __forceinline__ void init(f32x4 (&acc)[2][2][4][2], const Unit& u, int wr, int wc, int fr, int fq) const {
        const int col0 = u.pn * BM + wc * 32 + 4 * fq;
#pragma unroll
        for (int ai = 0; ai < 2; ++ai)
#pragma unroll
            for (int m = 0; m < 4; ++m) { const size_t off = (size_t)(u.pm * BM + ai * HALF + wr * 64 + m * 16 + fr) * ldc + col0;
#pragma unroll
                for (int bj = 0; bj < 2; ++bj)
#pragma unroll
                    for (int n = 0; n < 2; ++n) acc[ai][bj][m][n] = *(const f32x4*)(base + off + bj * HALF + n * 16); }
    }
    __device__ __forceinline__ void fused(f32x4 (&acc)[2][2][4][2], const Unit& u, int wr, int wc, int fr, int fq, LAS unsigned char* lds, int wid, int lane) const {
        LAS float* P = (LAS float*)lds;
        const int col0 = u.pn * BM + wc * 32 + 4 * fq;
#pragma unroll
        for (int ai = 0; ai < 2; ++ai)
#pragma unroll
            for (int m = 0; m < 4; ++m) { const int r = ai * HALF + wr * 64 + m * 16 + fr; const size_t off = (size_t)(u.pm * BM + r) * ldc + col0; float s = 0.f;
#pragma unroll
                for (int bj = 0; bj < 2; ++bj)
#pragma unroll
                    for (int n = 0; n < 2; ++n) { const f32x4 o = acc[ai][bj][m][n];
                        if (out) *(f32x4*)(out + off + bj * HALF + n * 16) = o;
                        if (outb) { u32x2 w; w.x = cvt_pk_bf16(o[0], o[1]); w.y = cvt_pk_bf16(o[2], o[3]); *(u32x2*)(outb + off + bj * HALF + n * 16) = w; }
                        s += (o[0] * o[0] + o[1] * o[1]) + (o[2] * o[2] + o[3] * o[3]); }
                s += __shfl_xor(s, 16); s += __shfl_xor(s, 32);
                if (fq == 0) P[r * 4 + wc] = s;
                asm volatile("" ::: "memory"); }
        __syncthreads();
        const int tid = wid * 64 + lane;
        if (tid < 256) { const float s = (P[tid * 4 + 0] + P[tid * 4 + 1]) + (P[tid * 4 + 2] + P[tid * 4 + 3]); ssp[(size_t)(u.pm * BM + tid) * 8 + u.pn] = s; }
        __syncthreads();
    }
};

struct EpiFinal {
    static constexpr bool PERM = false, AFTER_DRAIN = true, INIT = true;
    float* out; int ldc; float* ssp; unsigned* cnt; const float* fnw; const bf16_t* hb;
    __device__ __forceinline__ void init(f32x4 (&acc)[2][2][4][2], const Unit& u, int wr, int wc, int fr, int fq) const {
        const int col0 = u.pn * BM + wc * 32 + 4 * fq;
#pragma unroll
        for (int ai = 0; ai < 2; ++ai)
#pragma unroll
            for (int m = 0; m < 4; ++m) { const size_t off = (size_t)(u.pm * BM + ai * HALF + wr * 64 + m * 16 + fr) * ldc + col0;
#pragma unroll
                for (int bj = 0; bj < 2; ++bj)
#pragma unroll
                    for (int n = 0; n < 2; ++n) { const u32x2 w = *(const u32x2*)(hb + off + bj * HALF + n * 16); acc[ai][bj][m][n] = (f32x4){__uint_as_float(w.x << 16), __uint_as_float(w.x & 0xffff0000u), __uint_as_float(w.y << 16), __uint_as_float(w.y & 0xffff0000u)}; } }
    }
    __device__ __forceinline__ void fused(f32x4 (&acc)[2][2][4][2], const Unit& u, int wr, int wc, int fr, int fq, LAS unsigned char* lds, int wid, int lane) const {
        LAS float* P = (LAS float*)lds;
        LAS float* R = (LAS float*)(lds + 4096);
        const int col0 = u.pn * BM + wc * 32 + 4 * fq;
#pragma unroll
        for (int ai = 0; ai < 2; ++ai)
#pragma unroll
            for (int m = 0; m < 4; ++m) { const int r = ai * HALF + wr * 64 + m * 16 + fr; const size_t off = (size_t)(u.pm * BM + r) * ldc + col0; float s = 0.f;
#pragma unroll
                for (int bj = 0; bj < 2; ++bj)
#pragma unroll
                    for (int n = 0; n < 2; ++n) { const f32x4 o = acc[ai][bj][m][n];
                        s += (o[0] * o[0] + o[1] * o[1]) + (o[2] * o[2] + o[3] * o[3]); }
                s += __shfl_xor(s, 16); s += __shfl_xor(s, 32);
                if (fq == 0) P[r * 4 + wc] = s;
                asm volatile("" ::: "memory"); }
        __syncthreads();
        const int tid = wid * 64 + lane;
        float* slot = ssp + (size_t)(u.pm * BM + (tid & 255)) * 8;
        if (tid < 256) { const float s = (P[tid * 4 + 0] + P[tid * 4 + 1]) + (P[tid * 4 + 2] + P[tid * 4 + 3]); __hip_atomic_store(slot + u.pn, s, __ATOMIC_RELAXED, __HIP_MEMORY_SCOPE_AGENT); }
        asm volatile("s_waitcnt vmcnt(0)" ::: "memory");
        __syncthreads();
        if (tid == 0) {
            unsigned* c = cnt + 64 * u.pm;
            __hip_atomic_fetch_add(c, 1u, __ATOMIC_RELAXED, __HIP_MEMORY_SCOPE_AGENT);
            unsigned sp = 0;
            while (__hip_atomic_load(c, __ATOMIC_RELAXED, __HIP_MEMORY_SCOPE_AGENT) < 8u) { __builtin_amdgcn_s_sleep(1); if (++sp > (1u << 24)) break; }
            __builtin_amdgcn_fence(__ATOMIC_ACQUIRE, "agent");
            asm volatile("s_waitcnt vmcnt(0)" ::: "memory");
        }
        __syncthreads();
        if (tid < 256) { float ss = 0.f;
#pragma unroll
            for (int j = 0; j < 8; ++j) ss += __hip_atomic_load(slot + j, __ATOMIC_RELAXED, __HIP_MEMORY_SCOPE_AGENT);
            R[tid] = 1.0f / sqrtf(ss * (1.0f / DM) + EPS); }
        __syncthreads();
#pragma unroll
        for (int ai = 0; ai < 2; ++ai)
#pragma unroll
            for (int m = 0; m < 4; ++m) { const int r = ai * HALF + wr * 64 + m * 16 + fr; const size_t off = (size_t)(u.pm * BM + r) * ldc + col0; const float rs = R[r];
#pragma unroll
                for (int bj = 0; bj < 2; ++bj)
#pragma unroll
                    for (int n = 0; n < 2; ++n) { const f32x4 fw = *(const f32x4*)(fnw + col0 + bj * HALF + n * 16); *(f32x4*)(out + off + bj * HALF + n * 16) = acc[ai][bj][m][n] * rs * fw; } }
    }
};
}

__device__ __forceinline__ int win_map(int n) { return n < 3072 ? n : (n < 3088 ? n + 1024 : n - 16); }
struct P0Desc { const float* src; const float* scale; bf16_t* dst; int ldn, K, n0, N, k0, map, ldk; };
__device__ __forceinline__ P0Desc p0_decode(const Params& p, unsigned char* ws, int it) {
    constexpr int I_1 = 32 * 128, I_2 = 128 * 32, I_IN = 32 * 65, I_OUT = 32 * 32;
    P0Desc d; int r = it, nblk;
    if (r < I_1) { d.src = p.mlp_w1; d.scale = p.norm2_w; d.dst = (bf16_t*)(ws + OFF_W1T); d.ldn = DFF; d.K = DM; d.N = DFF; d.map = 0; nblk = 128; }
    else if ((r -= I_1) < I_2) { d.src = p.mlp_w2; d.scale = nullptr; d.dst = (bf16_t*)(ws + OFF_W2T); d.ldn = DM; d.K = DFF; d.N = DM; d.map = 0; nblk = 32; }
    else if ((r -= I_2) < I_IN) { d.src = p.w_in; d.scale = p.norm1_w; d.dst = (bf16_t*)(ws + OFF_WINT); d.ldn = DIN; d.K = DM; d.N = DIN; d.map = 1; nblk = 65; }
    else if ((r -= I_IN) < I_OUT) { d.src = p.w_out; d.scale = nullptr; d.dst = (bf16_t*)(ws + OFF_WOUTT); d.ldn = DM; d.K = DM; d.N = DM; d.map = 0; nblk = 32; }
    else { r -= I_OUT; const int g = r >> 4; r &= 15; d.src = p.pool_w + (size_t)g * 65536; d.scale = nullptr; d.dst = (bf16_t*)(ws + OFF_POOLWT) + (size_t)g * 65536; d.ldn = 256; d.K = 256; d.N = 256; d.map = 0; nblk = 4; }
    d.ldk = d.map ? XLD : d.K;
    const int nkb = d.K >> 6; const int nb = r / nkb, kb = r - nb * nkb; d.k0 = kb * 64; d.n0 = nb * 64;
    return d;
}
#define P0_LOAD(d, v) do { const int _n = (d).n0 + lane; const float* _s = (d).src + (size_t)(d).k0 * (d).ldn + (_n < (d).N ? _n : 0); \
    _Pragma("unroll") for (int _i = 0; _i < 64; ++_i) v[_i] = _s[(size_t)_i * (d).ldn]; } while (0)
__device__ __forceinline__ void p0_rows2(const float* r0, const float* r1, bf16_t* o0, bf16_t* o1, bool two, int lane) {
    const f32x4* x0 = (const f32x4*)r0 + lane; const f32x4* x1 = (const f32x4*)r1 + lane; f32x4 v[8], w[8]; float s0 = 0.f, s1 = 0.f;
#pragma unroll
    for (int j = 0; j < 8; ++j) v[j] = x0[64 * j];
    if (two) {
#pragma unroll
        for (int j = 0; j < 8; ++j) w[j] = x1[64 * j];
    } else {
#pragma unroll
        for (int j = 0; j < 8; ++j) w[j] = (f32x4){0.f, 0.f, 0.f, 0.f};
    }
#pragma unroll
    for (int j = 0; j < 8; ++j) { s0 += (v[j][0] * v[j][0] + v[j][1] * v[j][1]) + (v[j][2] * v[j][2] + v[j][3] * v[j][3]); s1 += (w[j][0] * w[j][0] + w[j][1] * w[j][1]) + (w[j][2] * w[j][2] + w[j][3] * w[j][3]); }
    const float rs0 = 1.0f / sqrtf(wave_sum(s0) * (1.0f / DM) + EPS), rs1 = 1.0f / sqrtf(wave_sum(s1) * (1.0f / DM) + EPS);
    u32x2* q0 = (u32x2*)o0 + lane; u32x2* q1 = (u32x2*)o1 + lane;
#pragma unroll
    for (int j = 0; j < 8; ++j) { u32x2 t; t.x = cvt_pk_bf16(v[j][0] * rs0, v[j][1] * rs0); t.y = cvt_pk_bf16(v[j][2] * rs0, v[j][3] * rs0); q0[64 * j] = t; }
    if (two) {
#pragma unroll
        for (int j = 0; j < 8; ++j) { u32x2 t; t.x = cvt_pk_bf16(w[j][0] * rs1, w[j][1] * rs1); t.y = cvt_pk_bf16(w[j][2] * rs1, w[j][3] * rs1); q1[64 * j] = t; }
    }
}
__device__ __forceinline__ void phase0(const Params& p, unsigned char* lds) {
    const int tid = opaque_tid(), lane = tid & 63, wave = tid >> 6;
    LAS float* scr = (LAS float*)((LAS unsigned char*)lds + wave * 16640);
    const int gw = blockIdx.x * 8 + wave, NGW = NBLK * 8;
    unsigned char* ws = p.ws;
    constexpr int NITEMS = 32 * 128 + 128 * 32 + 32 * 65 + 32 * 32 + 4 * 16;
    float v[64];
    int it = (int)(((long)gw * NITEMS) / NGW); const int it_end = (int)(((long)(gw + 1) * NITEMS) / NGW);
    P0Desc d = p0_decode(p, ws, it < it_end ? it : 0);
    if (it < it_end) P0_LOAD(d, v);
    while (it < it_end) {
        const bool ok = d.n0 + lane < d.N;
#pragma unroll
        for (int i = 0; i < 64; ++i) { const float sc = d.scale ? d.scale[d.k0 + i] : 1.0f; scr[i * 65 + lane] = ok ? v[i] * sc : 0.f; }
        asm volatile("s_waitcnt lgkmcnt(0)" ::: "memory"); __builtin_amdgcn_wave_barrier();
        const P0Desc c = d;
        it += 1;
        if (it < it_end) { d = p0_decode(p, ws, it); P0_LOAD(d, v); }
#pragma unroll
        for (int j = 0; j < 8; ++j) { const int pc = lane + 64 * j, nn = pc >> 3, cc = pc & 7; const LAS float* s = scr + (8 * cc) * 65 + nn;
            u32x4 o; o.x = cvt_pk_bf16(s[0], s[65]); o.y = cvt_pk_bf16(s[2 * 65], s[3 * 65]); o.z = cvt_pk_bf16(s[4 * 65], s[5 * 65]); o.w = cvt_pk_bf16(s[6 * 65], s[7 * 65]);
            const int ng = c.n0 + nn;
            if (ng < c.N) { const int row = c.map ? win_map(ng) : ng; *(u32x4*)(c.dst + (size_t)row * c.ldk + c.k0 + 8 * cc) = o; } }
        asm volatile("s_waitcnt lgkmcnt(0)" ::: "memory"); __builtin_amdgcn_wave_barrier();
    }
    {
        bf16_t* xb = (bf16_t*)(ws + OFF_XB);
        const int r0 = 1024 * (blockIdx.x & 7) + ((blockIdx.x >> 3) * 8 + wave);
#pragma unroll 1
        for (int i = 0; i < 4; i += 2) { const int m = r0 + 256 * i, m2 = m + 256;
            p0_rows2(p.x + (size_t)m * DM, p.x + (size_t)m2 * DM, xb + (size_t)m * XLD, xb + (size_t)m2 * XLD, true, lane); }
        if (gw < NMETA) { const float* sm = p.meta + (size_t)gw * DM; bf16_t* om = xb + (size_t)(MR + gw) * XLD; p0_rows2(sm, sm, om, om, false, lane); }
    }
}

__device__ __forceinline__ void phase1_skinny(const Params& p, unsigned char* lds) {
    const int tid = opaque_tid(), lane = tid & 63, wave = tid >> 6;
    unsigned char* ws = p.ws;
    const bf16_t* xb = (const bf16_t*)(ws + OFF_XB); const bf16_t* wint = (const bf16_t*)(ws + OFF_WINT);
    f32x4* red = (f32x4*)lds;
#pragma unroll 1
    for (int task = blockIdx.x; task < 513 + 256; task += NBLK) {
        const bf16_t* Mrows = task < 513 ? xb + (size_t)task * 16 * XLD : xb + (size_t)MR * XLD;
        const bf16_t* Nrows = task < 513 ? wint + (size_t)4096 * XLD : wint + (size_t)(task - 513) * 16 * XLD;
        const bf16x8* mp = (const bf16x8*)(Mrows + (size_t)(lane & 15) * XLD + wave * 256 + 8 * (lane >> 4));
        const bf16x8* np = (const bf16x8*)(Nrows + (size_t)(lane & 15) * XLD + wave * 256 + 8 * (lane >> 4));
        bf16x8 mf[8], nf[8];
#pragma unroll
        for (int kk = 0; kk < 8; ++kk) { mf[kk] = mp[kk * 4]; nf[kk] = np[kk * 4]; }
        f32x4 a = {0.f, 0.f, 0.f, 0.f};
#pragma unroll
        for (int kk = 0; kk < 8; ++kk) a = mfma16(nf[kk], mf[kk], a);
        red[wave * 64 + lane] = a;
        lds_barrier();
        if (wave == 0) {
            f32x4 sacc = red[lane];
#pragma unroll
            for (int w = 1; w < 8; ++w) sacc += red[w * 64 + lane];
            if (task < 513) *(f32x4*)((float*)(ws + OFF_GLR) + (size_t)(task * 16 + (lane & 15)) * 16 + 4 * (lane >> 4)) = sacc;
            else { u32x2 w; w.x = cvt_pk_bf16(sacc[0], sacc[1]); w.y = cvt_pk_bf16(sacc[2], sacc[3]);
                *(u32x2*)((bf16_t*)(ws + OFF_PROJ) + (size_t)(MR + (lane & 15)) * PLD + (task - 513) * 16 + 4 * (lane >> 4)) = w; }
        }
        lds_barrier();
    }
}

constexpr int L_GLR = 0, L_W2 = 4096, L_GSUM = 12288, L_QD = 14336, L_KI = 31744, L_KET = 49152, L_VT = 67584, L_P = 104448;
struct GlaIn { bf16_t qv[16], kv[16], vv[32]; f32x4 glrv, w2v; float gb; };
__device__ __forceinline__ void gla_a_load(const Params& p, int u, GlaIn& r) {
    const int tid = opaque_tid();
    unsigned char* ws = p.ws;
    const bool meta = u >= 512;
    const int h = meta ? (u - 512) : ((u >> 5) & 3);
    const int row0 = meta ? MR : ((u >> 7) * 2048 + (u & 31) * 64);
    const int nvalid = meta ? NMETA : 64;
    const bf16_t* proj = (const bf16_t*)(ws + OFF_PROJ);
    const float* glr = (const float*)(ws + OFF_GLR);
    const int d = tid & 127, tq = tid >> 7, dvc = tid & 255, th = tid >> 8;
#pragma unroll
    for (int i = 0; i < 16; ++i) { const int t = tq * 16 + i, tc = t < nvalid ? t : nvalid - 1; const bf16_t* pr = proj + (size_t)(row0 + tc) * PLD + h * 128 + d; r.qv[i] = pr[0]; r.kv[i] = pr[512]; }
#pragma unroll
    for (int i = 0; i < 32; ++i) { const int t = th * 32 + i, tc = t < nvalid ? t : nvalid - 1; r.vv[i] = proj[(size_t)(row0 + tc) * PLD + 1024 + h * 256 + dvc]; }
    r.gb = p.gate_b[h * 128 + d];
    { const int rr = (tid & 255) >> 2, part = tid & 3, rc = rr < nvalid ? rr : nvalid - 1; r.glrv = *(const f32x4*)(glr + (size_t)(row0 + rc) * 16 + part * 4); }
    { const int idx = tid * 4, j = idx >> 7, dd = idx & 127; r.w2v = *(const f32x4*)(p.gate_w2 + j * 512 + h * 128 + dd); }
}
__device__ __forceinline__ void gla_a_compute(const Params& p, unsigned char* lds, int u, const GlaIn& r) {
    const int tid = opaque_tid(), lane = tid & 63, wave = tid >> 6, fr = lane & 15, fq = lane >> 4;
    unsigned char* ws = p.ws;
    const bool meta = u >= 512;
    const int h = meta ? (u - 512) : ((u >> 5) & 3);
    const int row0 = meta ? MR : ((u >> 7) * 2048 + (u & 31) * 64);
    const int nvalid = meta ? NMETA : 64;
    bf16_t* proj = (bf16_t*)(ws + OFF_PROJ);
    float* glr_s = (float*)(lds + L_GLR); float* w2_s = (float*)(lds + L_W2); float* gsum = (float*)(lds + L_GSUM);
    bf16_t* qd_s = (bf16_t*)(lds + L_QD); bf16_t* ki_s = (bf16_t*)(lds + L_KI); bf16_t* ket_s = (bf16_t*)(lds + L_KET); bf16_t* vt_s = (bf16_t*)(lds + L_VT);
    const int d = tid & 127, tq = tid >> 7, dvc = tid & 255, th = tid >> 8;
    const float gb = r.gb;
    if (tid < 256) { const int rr = tid >> 2, part = tid & 3; *(f32x4*)(glr_s + rr * 16 + part * 4) = rr < nvalid ? r.glrv : (f32x4){0.f, 0.f, 0.f, 0.f}; }
    *(f32x4*)(w2_s + tid * 4) = r.w2v;
    lds_barrier();
    {
        float w2c[16];
#pragma unroll
        for (int j = 0; j < 16; ++j) w2c[j] = w2_s[j * 128 + d];
        float G[16]; float run = 0.f;
#pragma unroll
        for (int i = 0; i < 16; ++i) { const int t = tq * 16 + i; const float* gr = glr_s + t * 16; float g = gb;
#pragma unroll
            for (int j = 0; j < 16; ++j) g += gr[j] * w2c[j];
            float lg = (fminf(g, 0.f) - __logf(1.0f + __expf(-fabsf(g)))) * (1.0f / 16.0f);
            if (t >= nvalid) lg = 0.f;
            run += lg; G[i] = run; }
        gsum[tq * 128 + d] = run;
        lds_barrier();
        float off = 0.f, tot = 0.f;
#pragma unroll
        for (int q = 0; q < 4; ++q) { const float sg = gsum[q * 128 + d]; tot += sg; if (q < tq) off += sg; }
#pragma unroll
        for (int i = 0; i < 16; ++i) { const int t = tq * 16 + i; const float Gt = off + G[i];
            const float q = t < nvalid ? bf2f(r.qv[i]) : 0.f, k = t < nvalid ? bf2f(r.kv[i]) : 0.f;
            const bf16_t qdb = f2bf(q * 0.08838834764831845f * __expf(Gt));
            qd_s[t * 136 + d] = qdb; ki_s[t * 136 + d] = f2bf(k * __expf(-Gt)); ket_s[d * 72 + t] = f2bf(k * __expf(tot - Gt));
            if (!meta) proj[(size_t)(row0 + t) * PLD + h * 128 + d] = qdb; }
        if (tq == 0) ((float*)(ws + OFF_DECAY))[u * 128 + d] = __expf(tot);
    }
#pragma unroll
    for (int i = 0; i < 32; ++i) { const int t = th * 32 + i; vt_s[dvc * 72 + t] = t < nvalid ? r.vv[i] : (bf16_t)0; }
    lds_barrier();
    if (!meta) {
#pragma unroll
        for (int ii = 0; ii < 2; ++ii) { const int idx = 2 * wave + ii, tt = idx >> 2, ss = idx & 3; f32x4 acc = {0.f, 0.f, 0.f, 0.f};
            if (ss <= tt) {
#pragma unroll
                for (int kk = 0; kk < 4; ++kk) { const bf16x8 mf = *(const bf16x8*)(lds + L_QD + (tt * 16 + fr) * 272 + (kk * 32 + 8 * fq) * 2);
                    const bf16x8 nf = *(const bf16x8*)(lds + L_KI + (ss * 16 + fr) * 272 + (kk * 32 + 8 * fq) * 2); acc = mfma16(nf, mf, acc); } }
            const int t = tt * 16 + fr, s0 = ss * 16 + 4 * fq;
#pragma unroll
            for (int j = 0; j < 4; ++j) if (s0 + j > t) acc[j] = 0.f;
            u32x2 w; w.x = cvt_pk_bf16(acc[0], acc[1]); w.y = cvt_pk_bf16(acc[2], acc[3]);
            *(u32x2*)(lds + L_P + t * 144 + s0 * 2) = w; }
    }
    lds_barrier();
    if (!meta) {
        f32x4 o[4][2];
#pragma unroll
        for (int tt = 0; tt < 4; ++tt) { o[tt][0] = (f32x4){0.f, 0.f, 0.f, 0.f}; o[tt][1] = (f32x4){0.f, 0.f, 0.f, 0.f}; }
#pragma unroll
        for (int kk = 0; kk < 2; ++kk) { bf16x8 nf[2];
#pragma unroll
            for (int dd = 0; dd < 2; ++dd) nf[dd] = *(const bf16x8*)(lds + L_VT + (wave * 32 + dd * 16 + fr) * 144 + (kk * 32 + 8 * fq) * 2);
#pragma unroll
            for (int tt = 0; tt < 4; ++tt) { const bf16x8 mf = *(const bf16x8*)(lds + L_P + (tt * 16 + fr) * 144 + (kk * 32 + 8 * fq) * 2);
                o[tt][0] = mfma16(nf[0], mf, o[tt][0]); o[tt][1] = mfma16(nf[1], mf, o[tt][1]); } }
        u32x2* dump = (u32x2*)(ws + OFF_OINTRA) + ((size_t)(u * 8 + wave) * 8) * 64 + lane;
#pragma unroll
        for (int tt = 0; tt < 4; ++tt)
#pragma unroll
            for (int dd = 0; dd < 2; ++dd) { u32x2 w; w.x = cvt_pk_bf16(o[tt][dd][0], o[tt][dd][1]); w.y = cvt_pk_bf16(o[tt][dd][2], o[tt][dd][3]); dump[(tt * 2 + dd) * 64] = w; }
    }
    {
        bf16_t* dsb = meta ? (bf16_t*)(ws + OFF_DSMETA) + (size_t)h * 32768 : (bf16_t*)p.out + (size_t)u * 32768;
#pragma unroll
        for (int dvt = 0; dvt < 2; ++dvt) { f32x4 acc[8];
#pragma unroll
            for (int i = 0; i < 8; ++i) acc[i] = (f32x4){0.f, 0.f, 0.f, 0.f};
#pragma unroll
            for (int kk = 0; kk < 2; ++kk) { const bf16x8 mf = *(const bf16x8*)(lds + L_VT + (wave * 32 + dvt * 16 + fr) * 144 + (kk * 32 + 8 * fq) * 2);
#pragma unroll
                for (int dkt = 0; dkt < 8; ++dkt) { const bf16x8 nf = *(const bf16x8*)(lds + L_KET + (dkt * 16 + fr) * 144 + (kk * 32 + 8 * fq) * 2); acc[dkt] = mfma16(nf, mf, acc[dkt]); } }
            bf16_t* dst = dsb + (size_t)(wave * 32 + dvt * 16 + fr) * 128 + 4 * fq;
#pragma unroll
            for (int dkt = 0; dkt < 8; ++dkt) { u32x2 w; w.x = cvt_pk_bf16(acc[dkt][0], acc[dkt][1]); w.y = cvt_pk_bf16(acc[dkt][2], acc[dkt][3]); *(u32x2*)(dst + dkt * 16) = w; } }
    }
    lds_barrier();
}
template <int W>
__device__ __forceinline__ void pool_y_rows(const bf16_t* __restrict__ proj, bf16_t* __restrict__ mixed, int b, int t0, int ch0) {
    u32x4 rows[8 + W];
#pragma unroll
    for (int i = 0; i < 8 + W; ++i) { const int tt = t0 - W + i; const size_t row = tt >= 0 ? (size_t)b * 2048 + tt : (size_t)(MR + NMETA + tt);
        rows[i] = *(const u32x4*)(proj + row * PLD + 3072 + ch0); }
    float sum[8];
#pragma unroll
    for (int e = 0; e < 8; ++e) sum[e] = 0.f;
#define POOL_UNPK(v, dst) do { dst[0] = __uint_as_float((v).x << 16); dst[1] = __uint_as_float((v).x & 0xffff0000u); dst[2] = __uint_as_float((v).y << 16); dst[3] = __uint_as_float((v).y & 0xffff0000u); \
        dst[4] = __uint_as_float((v).z << 16); dst[5] = __uint_as_float((v).z & 0xffff0000u); dst[6] = __uint_as_float((v).w << 16); dst[7] = __uint_as_float((v).w & 0xffff0000u); } while (0)
#pragma unroll
    for (int i = 1; i < W; ++i) { float v[8]; POOL_UNPK(rows[i], v);
#pragma unroll
        for (int e = 0; e < 8; ++e) sum[e] += v[e]; }
    constexpr float inv = 1.0f / (float)W;
#pragma unroll
    for (int i = 0; i < 8; ++i) { float nv[8]; POOL_UNPK(rows[W + i], nv);
        float y[8];
#pragma unroll
        for (int e = 0; e < 8; ++e) { sum[e] += nv[e]; y[e] = sum[e] * inv - nv[e]; }
        float ov[8]; POOL_UNPK(rows[i + 1], ov);
#pragma unroll
        for (int e = 0; e < 8; ++e) sum[e] -= ov[e];
        u32x4 o; o.x = cvt_pk_bf16(y[0], y[1]); o.y = cvt_pk_bf16(y[2], y[3]); o.z = cvt_pk_bf16(y[4], y[5]); o.w = cvt_pk_bf16(y[6], y[7]);
        *(u32x4*)(mixed + ((size_t)b * 2048 + t0 + i) * DM + ch0) = o; }
#undef POOL_UNPK
}
__device__ __forceinline__ void pool_y_task(const Params& p, int task) {
    const int tid = opaque_tid(), lane = tid & 63, wave = tid >> 6, g = wave >> 1;
    const int ch0 = g * 256 + (lane & 31) * 8;
    const int b = task >> 6, t0 = (task & 63) * 32 + (wave & 1) * 16 + (lane >> 5) * 8;
    const bf16_t* proj = (const bf16_t*)(p.ws + OFF_PROJ); bf16_t* mixed = (bf16_t*)(p.ws + OFF_MIXED);
    if (g == 0) pool_y_rows<2>(proj, mixed, b, t0, ch0);
    else if (g == 1) pool_y_rows<4>(proj, mixed, b, t0, ch0);
    else if (g == 2) pool_y_rows<8>(proj, mixed, b, t0, ch0);
    else pool_y_rows<16>(proj, mixed, b, t0, ch0);
}

__device__ __forceinline__ void gla_scan(const Params& p, const int e) {
    unsigned char* ws = p.ws;
    const int bh = e >> 13, rem = e & 8191, h = bh & 3;
    const size_t eo = (size_t)rem * 4;
    const int dk4 = (rem & 31) * 4;
    const u32x2 sm0 = *(const u32x2*)((const bf16_t*)(ws + OFF_DSMETA) + (size_t)h * 32768 + eo);
    f32x4 S = {__uint_as_float(sm0.x << 16), __uint_as_float(sm0.x & 0xffff0000u), __uint_as_float(sm0.y << 16), __uint_as_float(sm0.y & 0xffff0000u)};
    const bf16_t* ds = (const bf16_t*)p.out + (size_t)bh * 32 * 32768 + eo;
    const float* dec = (const float*)(ws + OFF_DECAY) + (size_t)bh * 32 * 128 + dk4;
    bf16_t* sp = (bf16_t*)(ws + OFF_SPREV) + (size_t)bh * 31 * 32768 + eo;
    bf16_t* sm = (bf16_t*)(ws + OFF_SMETAB) + (size_t)h * 32768 + eo;
    u32x2 d0[8], d1[8]; f32x4 a0[8], a1[8];
#define SCAN_LD(db, ab, c0) do { _Pragma("unroll") for (int _j = 0; _j < 8; ++_j) { db[_j] = *(const u32x2*)(ds + (size_t)((c0) + _j) * 32768); ab[_j] = *(const f32x4*)(dec + ((c0) + _j) * 128); } } while (0)
#define SCAN_DO(db, ab, c0) do { _Pragma("unroll") for (int _j = 0; _j < 8; ++_j) { const int _c = (c0) + _j; u32x2 _w; _w.x = cvt_pk_bf16(S[0], S[1]); _w.y = cvt_pk_bf16(S[2], S[3]); \
        if (_c == 0) { if (bh < 4) *(u32x2*)sm = _w; } else *(u32x2*)(sp + (size_t)(_c - 1) * 32768) = _w; \
        const f32x4 _d = {__uint_as_float(db[_j].x << 16), __uint_as_float(db[_j].x & 0xffff0000u), __uint_as_float(db[_j].y << 16), __uint_as_float(db[_j].y & 0xffff0000u)}; \
        S = ab[_j] * S + _d; } } while (0)
    SCAN_LD(d0, a0, 0); SCAN_LD(d1, a1, 8);
    SCAN_DO(d0, a0, 0); SCAN_LD(d0, a0, 16);
    SCAN_DO(d1, a1, 8); SCAN_LD(d1, a1, 24);
    SCAN_DO(d0, a0, 16);
    SCAN_DO(d1, a1, 24);
#undef SCAN_LD
#undef SCAN_DO
}

__device__ __forceinline__ void gla_c_unit(const Params& p, unsigned char* lds, int u) {
    const int tid = opaque_tid(), lane = tid & 63, wave = tid >> 6, fr = lane & 15, fq = lane >> 4;
    unsigned char* ws = p.ws;
    const int h = (u >> 5) & 3, row0 = (u >> 7) * 2048 + (u & 31) * 64;
    const bf16_t* proj = (const bf16_t*)(ws + OFF_PROJ);
    f32x4 o[4][2];
    const u32x2* dump = (const u32x2*)(ws + OFF_OINTRA) + ((size_t)(u * 8 + wave) * 8) * 64 + lane;
    const bf16_t* qbase = proj + (size_t)(row0 + fr) * PLD + h * 128 + 8 * fq;
    const int cch = u & 31, bhh = u >> 5;
    const bf16_t* sbase = (cch == 0 ? (const bf16_t*)(ws + OFF_SMETAB) + (size_t)h * 32768 : (const bf16_t*)(ws + OFF_SPREV) + (size_t)(bhh * 31 + cch - 1) * 32768) + (size_t)(wave * 32 + fr) * 128 + 8 * fq;
    bf16x8 nf[4][2], mf[4][4]; u32x2 rr[4][2]; f32x4 nw[2];
#pragma unroll
    for (int kk = 0; kk < 4; ++kk) {
#pragma unroll
        for (int dd = 0; dd < 2; ++dd) nf[kk][dd] = *(const bf16x8*)(sbase + dd * 16 * 128 + kk * 32);
#pragma unroll
        for (int tt = 0; tt < 4; ++tt) mf[kk][tt] = *(const bf16x8*)(qbase + (size_t)tt * 16 * PLD + kk * 32); }
#pragma unroll
    for (int tt = 0; tt < 4; ++tt)
#pragma unroll
        for (int dd = 0; dd < 2; ++dd) { const u32x2 w = dump[(tt * 2 + dd) * 64]; o[tt][dd] = (f32x4){__uint_as_float(w.x << 16), __uint_as_float(w.x & 0xffff0000u), __uint_as_float(w.y << 16), __uint_as_float(w.y & 0xffff0000u)}; }
#pragma unroll
    for (int tt = 0; tt < 4; ++tt)
#pragma unroll
        for (int dd = 0; dd < 2; ++dd) rr[tt][dd] = *(const u32x2*)(proj + (size_t)(row0 + tt * 16 + fr) * PLD + 2048 + h * 256 + wave * 32 + dd * 16 + 4 * fq);
#pragma unroll
    for (int dd = 0; dd < 2; ++dd) nw[dd] = *(const f32x4*)(p.gla_norm_w + wave * 32 + dd * 16 + 4 * fq);
#pragma unroll
    for (int kk = 0; kk < 4; ++kk)
#pragma unroll
        for (int tt = 0; tt < 4; ++tt) { o[tt][0] = mfma16(nf[kk][0], mf[kk][tt], o[tt][0]); o[tt][1] = mfma16(nf[kk][1], mf[kk][tt], o[tt][1]); }
    float* ssq = (float*)lds;
#pragma unroll
    for (int tt = 0; tt < 4; ++tt) { float s = 0.f;
#pragma unroll
        for (int dd = 0; dd < 2; ++dd) s += (o[tt][dd][0] * o[tt][dd][0] + o[tt][dd][1] * o[tt][dd][1]) + (o[tt][dd][2] * o[tt][dd][2] + o[tt][dd][3] * o[tt][dd][3]);
        s += __shfl_xor(s, 16); s += __shfl_xor(s, 32);
        if (fq == 0) ssq[(tt * 16 + fr) * 8 + wave] = s; }
    lds_barrier();
    bf16_t* mixed = (bf16_t*)(ws + OFF_MIXED);
#pragma unroll
    for (int tt = 0; tt < 4; ++tt) { const int t = tt * 16 + fr;
        const f32x4 a = *(const f32x4*)(ssq + t * 8), b = *(const f32x4*)(ssq + t * 8 + 4);
        const float tot = ((a[0] + a[1]) + (a[2] + a[3])) + ((b[0] + b[1]) + (b[2] + b[3]));
        const float rstd = 1.0f / sqrtf(tot * (1.0f / 256.0f) + EPS);
#pragma unroll
        for (int dd = 0; dd < 2; ++dd) { const int dv = wave * 32 + dd * 16 + 4 * fq;
            const u32x2 rv = rr[tt][dd];
            float r[4] = {__uint_as_float(rv.x << 16), __uint_as_float(rv.x & 0xffff0000u), __uint_as_float(rv.y << 16), __uint_as_float(rv.y & 0xffff0000u)};
            float y[4];
#pragma unroll
            for (int j = 0; j < 4; ++j) y[j] = o[tt][dd][j] * rstd * nw[dd][j] * (r[j] / (1.0f + __expf(-r[j])));
            u32x2 w; w.x = cvt_pk_bf16(y[0], y[1]); w.y = cvt_pk_bf16(y[2], y[3]);
            *(u32x2*)(mixed + (size_t)(row0 + t) * DM + h * 256 + dv) = w; } }
    lds_barrier();
}

__device__ __forceinline__ void phase6(const Params& p) {
    const int tid = opaque_tid(), lane = tid & 63, wave = tid >> 6, gw = blockIdx.x * 8 + wave;
    const float* ssp = (const float*)(p.ws + OFF_SS3P);
    f32x4 fw[8];
#pragma unroll
    for (int j = 0; j < 8; ++j) fw[j] = ((const f32x4*)p.final_norm_w)[lane + 64 * j];
    for (int m = gw; m < MR; m += NBLK * 8) {
        const f32x4 p0 = *(const f32x4*)(ssp + (size_t)m * 8), p1 = *(const f32x4*)(ssp + (size_t)m * 8 + 4);
        const float ss = ((p0[0] + p0[1]) + (p0[2] + p0[3])) + ((p1[0] + p1[1]) + (p1[2] + p1[3]));
        const float rstd = 1.0f / sqrtf(ss * (1.0f / DM) + EPS);
        f32x4* row = (f32x4*)(p.out + (size_t)m * DM) + lane;
#pragma unroll
        for (int j = 0; j < 8; ++j) { f32x4 v = row[64 * j]; row[64 * j] = v * rstd * fw[j]; }
    }
}

__global__ void __launch_bounds__(NTHR, 2) hybrid_fwd(Params p) {
    extern __shared__ __attribute__((aligned(16))) unsigned char lds[];
    cg::grid_group grid = cg::this_grid();
    LAS unsigned char* ldsl = (LAS unsigned char*)lds;
    unsigned char* ws = p.ws;
    const int bx = blockIdx.x;
    const int xl = bx & 7, rk = bx >> 3;
    const int uA = (xl >> 1) * 128 + (2 * (rk >> 4)) * 32 + 16 * (xl & 1) + (rk & 15), uB = uA + 32;
    const int ptask = (xl >> 1) * 64 + (xl & 1) * 32 + rk;
    const int ptask_lo = (((bx - 4) & 7) >> 1) * 64 + (((bx - 4) & 7) & 1) * 32 + ((bx - 4) >> 3);

    volatile LAS unsigned* xst = (volatile LAS unsigned*)(ldsl + LDS_BYTES - 16);
    if (threadIdx.x < 4) xst[threadIdx.x] = 0u;
    unsigned* barw = (unsigned*)(ws + OFF_BAR);
    __syncthreads();
    XcdBarrier xb = xcd_barrier_post(barw, xst);
    if (p.stop == 0x7fffffff) grid.sync();

    phase0(p, lds);
    GSYNC();
#pragma unroll 1
    for (int _q = 1; _q < REP_P0; ++_q) { phase0(p, lds); GSYNC(); }

#pragma unroll 1
    for (int _q = 0; _q < REP_P1; ++_q) {
    phase1_skinny(p, lds);
    __syncthreads();
    {
        pg8::Gemm g{(const bf16_t*)(ws + OFF_XB), (const bf16_t*)(ws + OFF_WINT), MR, NPROJ, DM, XLD, XLD};
        pg8::StaticOrder S; S.init(MR, NPROJ, NBLK, bx);
        pg8::EpiBf16Scale E{(bf16_t*)(ws + OFF_PROJ), PLD, nullptr};
        pg8::gemm_phase<pg8::EpiBf16Scale>(ldsl, g, S, E);
    }
    GSYNC();
    }
    STOP_AT(1);

#if PROBE_STOP
    if (p.pad) { const int var = p.pad; GlaIn ra;
        if (!(var & 8)) { if (bx < 4 && !(var & 2)) { gla_a_load(p, 512 + bx, ra); gla_a_compute(p, lds, 512 + bx, ra); }
            gla_a_load(p, bx, ra); gla_a_compute(p, lds, bx, ra);
            if (!(var & 4)) { gla_a_load(p, bx + NBLK, ra); gla_a_compute(p, lds, bx + NBLK, ra); } }
        if (!(var & 1)) { if (bx >= 4) pool_y_task(p, bx); if (bx >= 4 && bx < 8) pool_y_task(p, bx - 4); }
    } else
#endif
    {
    {
        GlaIn ra, rb;
        if (bx < 4) { gla_a_load(p, 512 + bx, ra); gla_a_load(p, uA, rb); gla_a_compute(p, lds, 512 + bx, ra); gla_a_load(p, uB, ra); gla_a_compute(p, lds, uA, rb); gla_a_compute(p, lds, uB, ra); }
        else { gla_a_load(p, uA, ra); gla_a_load(p, uB, rb); gla_a_compute(p, lds, uA, ra); gla_a_compute(p, lds, uB, rb); }
    }
    if (bx >= 4) pool_y_task(p, ptask);
    if (bx >= 4 && bx < 8) pool_y_task(p, ptask_lo);
    }
    GSYNC();
    STOP_AT(2);

#pragma unroll 1
    for (int _q = 0; _q < REP_P2BC; ++_q) {
    if (bx < 128 && _q == 0) {
        const int gq = bx >> 5;
        pg8::Gemm g{(const bf16_t*)(ws + OFF_MIXED) + gq * 256, (const bf16_t*)(ws + OFF_POOLWT) + (size_t)gq * 65536, MR, 256, 256, DM, 256};
        pg8::StaticOrder S; S.init(MR, 256, 32, bx & 31);
        pg8::EpiBf16Scale E{(bf16_t*)(ws + OFF_MIXED) + 1024 + gq * 256, DM, p.pool_scale + gq * 256};
        pg8::gemm_phase<pg8::EpiBf16Scale>(ldsl, g, S, E);
    } else {
        const int li = ((bx >> 3) - 16) * 2 + (bx & 1);
        const int e0 = ((bx & 7) >> 1) * 32768 + li * NTHR + opaque_tid();
        gla_scan(p, e0);
        gla_scan(p, e0 + 16384);
    }
    GSYNC();
    STOP_AT(3);

    gla_c_unit(p, lds, uA); gla_c_unit(p, lds, uB);
    GSYNC();
    }
    STOP_AT(4);

#pragma unroll 1
    for (int _q = 0; _q < REP_P3; ++_q) {
    {
        pg8::Gemm g{(const bf16_t*)(ws + OFF_MIXED), (const bf16_t*)(ws + OFF_WOUTT), MR, DM, DM, DM, DM};
        pg8::StaticOrder S; S.init(MR, DM, NBLK, bx);
        pg8::EpiResid E{p.x, nullptr, (bf16_t*)(ws + OFF_H2B), DM, (float*)(ws + OFF_SS2P)};
        pg8::gemm_phase<pg8::EpiResid>(ldsl, g, S, E);
    }
    GSYNC();
    }
    STOP_AT(5);

#pragma unroll 1
    for (int _q = 0; _q < REP_P4; ++_q) {
    {
        pg8::Gemm g{(const bf16_t*)(ws + OFF_H2B), (const bf16_t*)(ws + OFF_W1T), MR, DFF, DM, DM, DM};
        pg8::StaticOrder S; S.init(MR, DFF, NBLK, bx, 1);
        LAS float* rl = (LAS float*)(ldsl + pg8::STAGE_BYTES);
        { const int t = opaque_tid(); const float* ssp = (const float*)(ws + OFF_SS2P);
#pragma unroll 1
          for (int i = 0; i < 4; ++i) { pg8::Unit uu; if (!S.next(i, uu)) break;
              if (t < 256) { const size_t row = (size_t)uu.pm * 256 + t; const f32x4 p0 = *(const f32x4*)(ssp + row * 8), p1 = *(const f32x4*)(ssp + row * 8 + 4);
                  rl[i * 256 + t] = 1.0f / sqrtf((((p0[0] + p0[1]) + (p0[2] + p0[3])) + ((p1[0] + p1[1]) + (p1[2] + p1[3]))) * (1.0f / DM) + EPS); } }
          __syncthreads(); }
        pg8::EpiSqRelu E{(bf16_t*)(ws + OFF_ACT), DFF, rl};
        pg8::gemm_phase<pg8::EpiSqRelu>(ldsl, g, S, E);
    }
    GSYNC();
    }
    STOP_AT(6);

    {
        pg8::Gemm g{(const bf16_t*)(ws + OFF_ACT), (const bf16_t*)(ws + OFF_W2T), MR, DM, DFF, DFF, DFF};
        pg8::StaticOrder S; S.init(MR, DM, NBLK, bx);
        pg8::EpiFinal E{p.out, DM, (float*)(ws + OFF_SS3P), (unsigned*)(ws + OFF_PCNT), p.final_norm_w, (const bf16_t*)(ws + OFF_H2B)};
        pg8::gemm_phase<pg8::EpiFinal>(ldsl, g, S, E);
    }
}

extern "C" void kernel_launch(void* const* d_in, const int* in_sizes, int n_in, void* d_out, int out_size, void* d_ws, size_t ws_size, hipStream_t stream) {
    static int ready = 0;
    if (!ready) {
        if (n_in != 14 || out_size != MR * DM || ws_size < WS_NEED) { fprintf(stderr, "kernel_launch: unexpected shapes (n_in %d, out %d, ws %zu)\n", n_in, out_size, ws_size); ready = -1; return; }
        if (hipFuncSetAttribute((const void*)hybrid_fwd, hipFuncAttributeMaxDynamicSharedMemorySize, LDS_BYTES) != hipSuccess) { fprintf(stderr, "kernel_launch: hipFuncSetAttribute failed\n"); ready = -1; return; }
        ready = 1;
    }
    if (ready < 0) return;
    Params p{};
    p.x = (const float*)d_in[0]; p.meta = (const float*)d_in[1]; p.norm1_w = (const float*)d_in[2]; p.w_in = (const float*)d_in[3];
    p.gate_w2 = (const float*)d_in[4]; p.gate_b = (const float*)d_in[5]; p.gla_norm_w = (const float*)d_in[6]; p.pool_w = (const float*)d_in[7];
    p.pool_scale = (const float*)d_in[8]; p.w_out = (const float*)d_in[9]; p.norm2_w = (const float*)d_in[10]; p.mlp_w1 = (const float*)d_in[11];
    p.mlp_w2 = (const float*)d_in[12]; p.final_norm_w = (const float*)d_in[13];
    p.out = (float*)d_out; p.ws = (unsigned char*)d_ws;
    p.stop = 99; p.pad = 0;
    if (hipMemsetAsync((unsigned char*)d_ws + OFF_BAR, 0, 16384 + 32 * 256, stream) != hipSuccess) { fprintf(stderr, "kernel_launch: memset failed\n"); return; }
#if PROBE_STOP
    { Params q = p; q.stop = PROBE_STOP; q.pad = PROBE_VAR; void* qa[] = {&q}; (void)hipLaunchCooperativeKernel((void*)hybrid_fwd, dim3(NBLK), dim3(NTHR), qa, LDS_BYTES, stream);
      (void)hipMemsetAsync((unsigned char*)d_ws + OFF_BAR, 0, 16384 + 32 * 256, stream); }
#endif
    void* args[] = {&p};
    hipError_t e = hipLaunchCooperativeKernel((void*)hybrid_fwd, dim3(NBLK), dim3(NTHR), args, LDS_BYTES, stream);
    if (e != hipSuccess) fprintf(stderr, "kernel_launch: cooperative launch failed: %s\n", hipGetErrorString(e));
}
```

```cpp
#include <hip/hip_runtime.h>
#include <hip/hip_cooperative_groups.h>
#include <cstdio>
namespace cg = cooperative_groups;
#ifndef REP_SYNC
#define REP_SYNC 1
#endif
#ifndef REP_P0
#define REP_P0 1
#endif
#ifndef REP_P1
#define REP_P1 1
#endif
#ifndef REP_P2BC
#define REP_P2BC 1
#endif
#ifndef REP_P3
#define REP_P3 1
#endif
#ifndef REP_P4
#define REP_P4 1
#endif
#ifndef PROBE_STOP
#define PROBE_STOP 0
#endif
#ifndef PROBE_VAR
#define PROBE_VAR 0
#endif
#define GSYNC() do { for (int _r = 0; _r < REP_SYNC; ++_r) xcd_barrier(xb); } while (0)
#define STOP_AT(k) do { if (PROBE_STOP && p.stop == (k)) return; } while (0)

#define LAS __attribute__((address_space(3)))
typedef unsigned short bf16_t;
typedef short bf16x8 __attribute__((ext_vector_type(8)));
typedef float f32x4 __attribute__((ext_vector_type(4)));
typedef unsigned u32x4 __attribute__((ext_vector_type(4)));
typedef unsigned u32x2 __attribute__((ext_vector_type(2)));

constexpr int DM = 2048, MR = 8192  , NMETA = 16, MA = MR + NMETA, DIN = 4112, NPROJ = 4096, PLD = 4160  , XLD = 2112  , DFF = 8192;
constexpr float EPS = 1e-6f;
constexpr int NBLK = 256, NTHR = 512;
constexpr int LDS_BYTES = 139264;

constexpr size_t SLOT = 33554432ull;
constexpr size_t OFF_WINT = 0;
constexpr size_t OFF_XB = 17369088;
constexpr size_t OFF_MIXED = 0;
constexpr size_t OFF_PROJ = 52039680;
constexpr size_t OFF_GLR = 120330240;
constexpr size_t OFF_DECAY = 120855552;
constexpr size_t OFF_DSMETA = 121119744;
constexpr size_t OFF_WOUTT = 123216896;
constexpr size_t OFF_POOLWT = 131605504;
constexpr size_t OFF_ACT = 0;
constexpr size_t OFF_W1T = 4 * SLOT;
constexpr size_t OFF_W2T = 5 * SLOT;
constexpr size_t OFF_OINTRA = 6 * SLOT;
constexpr size_t OFF_H2B = 6 * SLOT;
constexpr size_t OFF_SMETAB = 132129792;
constexpr size_t OFF_SPREV = 7 * SLOT;
constexpr size_t OFF_SS2P = 7 * SLOT + 32505856;
constexpr size_t OFF_SS3P = OFF_SS2P + 262144;
constexpr size_t OFF_BAR = OFF_SS3P + 262144;
constexpr size_t OFF_PCNT = OFF_BAR + 16384;
constexpr size_t WS_NEED = 8 * SLOT;

struct Params {
    const float *x, *meta, *norm1_w, *w_in, *gate_w2, *gate_b, *gla_norm_w, *pool_w, *pool_scale, *w_out, *norm2_w, *mlp_w1, *mlp_w2, *final_norm_w;
    float* out; unsigned char* ws; int stop; int pad;
};

typedef __bf16 hwbf16x2 __attribute__((ext_vector_type(2)));
typedef float f32x2v __attribute__((ext_vector_type(2)));
__device__ __forceinline__ unsigned cvt_pk_bf16(float lo, float hi) { const f32x2v f = {lo, hi}; const hwbf16x2 v = __builtin_convertvector(f, hwbf16x2); return __builtin_bit_cast(unsigned, v); }
__device__ __forceinline__ float bf2f(bf16_t u) { return __uint_as_float(((unsigned)u) << 16); }
__device__ __forceinline__ bf16_t f2bf(float f) { unsigned u = __float_as_uint(f); u += 0x7FFFu + ((u >> 16) & 1u); return (bf16_t)(u >> 16); }
__device__ __forceinline__ float wave_sum(float v) {
#pragma unroll
    for (int o = 1; o < 64; o <<= 1) v += __shfl_xor(v, o);
    return v;
}
__device__ __forceinline__ void lds_barrier() { asm volatile("s_waitcnt lgkmcnt(0)" ::: "memory"); __builtin_amdgcn_s_barrier(); asm volatile("" ::: "memory"); }
__device__ __forceinline__ int opaque_tid() { int t = threadIdx.x; asm volatile("" : "+v"(t)); return t; }
__device__ __forceinline__ f32x4 mfma16(bf16x8 a, bf16x8 b, f32x4 c) { return __builtin_amdgcn_mfma_f32_16x16x32_bf16(a, b, c, 0, 0, 0); }


#define XB_TMO      128
#define XB_XCNT(j)  (256  + 64 * (j))
#define XB_XSUB(j)  (1280 + 64 * (j))
#define XB_XGEN(j)  (2304 + 64 * (j))
#define XB_TOP      3328
#define XB_TOPGEN   3392
#define XCD_BAR_WORDS 3456
#define XB_SPIN_CAP (1u << 22)
__device__ __forceinline__ unsigned xb_ld(unsigned* p)              { return __hip_atomic_load(p, __ATOMIC_RELAXED, __HIP_MEMORY_SCOPE_AGENT); }
__device__ __forceinline__ unsigned xb_add(unsigned* p, unsigned v) { return __hip_atomic_fetch_add(p, v, __ATOMIC_RELAXED, __HIP_MEMORY_SCOPE_AGENT); }
__device__ __forceinline__ unsigned xb_xcc_id() { return (unsigned)__builtin_amdgcn_s_getreg((3 << 11) | 20) & 0xFu; }
#define XB_SPIN(cond, bar) do { unsigned _sp = 0; while (cond) { __builtin_amdgcn_s_sleep(1); \
    if ((++_sp & 255u) == 0u) { if (xb_ld(&(bar)[XB_TMO])) break; if (_sp > XB_SPIN_CAP) { atomicAdd(&(bar)[XB_TMO], 1u); break; } } } } while (0)
struct XcdBarrier { unsigned* bar; unsigned x; volatile LAS unsigned* st; };
__device__ __forceinline__ XcdBarrier xcd_barrier_post(unsigned* bar, volatile LAS unsigned* st) {
    XcdBarrier b; b.bar = bar; b.x = xb_xcc_id(); b.st = st;
    if (threadIdx.x == 0) (void)xb_add(&bar[XB_XCNT(b.x)], 1u);
    return b;
}
__device__ __forceinline__ void xcd_barrier_complete(unsigned* bar, unsigned x, unsigned& nloc, unsigned& nx) {
    const unsigned G = gridDim.x * gridDim.y * gridDim.z;
    unsigned sum, cnt, mine, sp = 0u;
    for (;;) {
        sum = 0u; cnt = 0u; mine = 0u;
#pragma unroll
        for (unsigned j = 0; j < 16; ++j) { const unsigned c = xb_ld(&bar[XB_XCNT(j)]); sum += c; cnt += (c > 0u) ? 1u : 0u; mine = (j == x) ? c : mine; }
        if (sum == G) break;
        __builtin_amdgcn_s_sleep(1);
        if ((++sp & 255u) == 0u) { if (xb_ld(&bar[XB_TMO])) break; if (sp > XB_SPIN_CAP) { atomicAdd(&bar[XB_TMO], 1u); break; } }
    }
    nloc = mine > 0u ? mine : 1u; nx = cnt > 0u ? cnt : 1u;
}
__device__ __forceinline__ void xcd_barrier(const XcdBarrier& b) {
    asm volatile("s_waitcnt vmcnt(0)" ::: "memory");
    __syncthreads();
    if (threadIdx.x == 0) {
        unsigned* bar = b.bar;
        __builtin_amdgcn_s_waitcnt(0);
        unsigned nloc = b.st[0], nx = b.st[1];
        if (nloc == 0u) { xcd_barrier_complete(bar, b.x, nloc, nx); b.st[0] = nloc; b.st[1] = nx; }
        const unsigned old = xb_add(&bar[XB_XSUB(b.x)], 1u);
        const unsigned gen = old / nloc;
        if (old + 1u == (gen + 1u) * nloc) {
            __builtin_amdgcn_fence(__ATOMIC_RELEASE, "agent");
            asm volatile("s_waitcnt vmcnt(0)" ::: "memory");
            const unsigned og = xb_add(&bar[XB_TOP], 1u);
            const unsigned tg = og / nx;
            if (og + 1u == (tg + 1u) * nx) xb_add(&bar[XB_TOPGEN], 1u);
            else XB_SPIN(xb_ld(&bar[XB_TOPGEN]) == tg, bar);
            __builtin_amdgcn_fence(__ATOMIC_ACQUIRE, "agent");
            xb_add(&bar[XB_XGEN(b.x)], 1u);
            asm volatile("s_waitcnt vmcnt(0)" ::: "memory");
        } else {
            XB_SPIN(xb_ld(&bar[XB_XGEN(b.x)]) == gen, bar);
            __builtin_amdgcn_fence(__ATOMIC_ACQUIRE, "agent");
            asm volatile("s_waitcnt vmcnt(0)" ::: "memory");
        }
    }
    __syncthreads();
}

namespace pg8 {
constexpr int BM = 256, BK = 64, HALF = 128, HTB = HALF * BK * 2, STAGE_BYTES = 8 * HTB, NXCD = 8, WGM = 4;
__device__ __forceinline__ int lds_byte(int r, int c) { const int st = (r >> 4) * 2 + (c >> 5), rr = r & 15, cc = c & 31, ob = rr * 64 + cc * 2; return st * 1024 + (ob ^ (((ob >> 9) & 1) << 5)); }
__device__ __forceinline__ void stage_rc(int b, int& R, int& C) { const int st = b / 1024, sb = b % 1024, swz = sb ^ (((sb >> 9) & 1) << 5); R = (st >> 1) * 16 + swz / 64; C = (st & 1) * 32 + (swz % 64) / 2; }
__device__ __forceinline__ int perm32(int rho) { const int n = rho >> 4, i = rho & 15; return 8 * (i >> 2) + 4 * n + (i & 3); }

struct Unit { int pm, pn; };
struct Gemm { const bf16_t* A; const bf16_t* Bt; int M, N, K, lda, ldb; };

struct StaticOrder {
    int nM, nN, nwg, G, c;
    __device__ void init(int M, int N, int G_, int c_) { nM = M / BM; nN = N / BM; nwg = nM * nN; G = G_; c = c_; }
    __device__ bool next(int i, Unit& u) const {
        const long L = (long)i * G + c; if (L >= nwg) return false;
        int wgid = (int)L; { const int q = nwg / NXCD, r = nwg % NXCD, xcd = wgid % NXCD, off = wgid / NXCD; wgid = (xcd < r ? xcd * (q + 1) : r * (q + 1) + (xcd - r) * q) + off; }
        const int nig = WGM * nN, gid = wgid / nig, fm = gid * WGM, gsz = (nM - fm) < WGM ? (nM - fm) : WGM;
        u.pm = fm + ((wgid % nig) % gsz); u.pn = (wgid % nig) / gsz; return true;
    }
};


template <class Epi>
__device__ __forceinline__ void gemm_phase(LAS unsigned char* lds, const Gemm g, const StaticOrder& S, const Epi& E) {
    const int tid = opaque_tid(), wid = __builtin_amdgcn_readfirstlane(tid >> 6), lane = tid & 63, wr = wid >> 2, wc = wid & 3, fr = lane & 15, fq = lane >> 4;
    const int K = g.K, nt = K / BK;
    unsigned voffA[2], voffB[2];
#pragma unroll
    for (int i = 0; i < 2; ++i) { int R, C; stage_rc(tid * 16 + i * 8192, R, C); const int Rb = Epi::PERM ? ((R & ~31) + perm32(R & 31)) : R;
        voffA[i] = (unsigned)(R * g.lda + C) * 2u; voffB[i] = (unsigned)(Rb * g.ldb + C) * 2u; }
    const size_t kstep = (size_t)(BK * 2);
    const size_t hstepA = (size_t)HALF * g.lda * 2, hstepB = (size_t)HALF * g.ldb * 2;
    const size_t tstepA = 2 * hstepA, tstepB = 2 * hstepB;
    const unsigned ldsw = (unsigned)wid * 1024u;
    const int aoff = lds_byte(wr * 64 + fr, fq * 8), boff = lds_byte(wc * 32 + fr, fq * 8);
#define PG8_SA(b, h) (((b) * 2 + (h)) * HTB)
#define PG8_SB(b, h) ((4 + (b) * 2 + (h)) * HTB)
#define PG8_STAGE(bufoff, gbase, voff) do { _Pragma("unroll") for (int _i = 0; _i < 2; ++_i) \
        __builtin_amdgcn_global_load_lds((const unsigned*)((const char*)(gbase) + (voff)[_i]), (LAS unsigned*)(lds + (bufoff) + ldsw + _i * 8192), 16, 0, 0); } while (0)
#define PG8_LDA(dst, b, h) do { _Pragma("unroll") for (int m = 0; m < 4; ++m) _Pragma("unroll") for (int k = 0; k < 2; ++k) dst[m][k] = *(const LAS bf16x8*)(lds + PG8_SA(b, h) + aoff + m * 2048 + k * 1024); } while (0)
#define PG8_LDB(dst, b, h) do { _Pragma("unroll") for (int n = 0; n < 2; ++n) _Pragma("unroll") for (int k = 0; k < 2; ++k) dst[n][k] = *(const LAS bf16x8*)(lds + PG8_SB(b, h) + boff + n * 2048 + k * 1024); } while (0)
#define PG8_MMA(ai, bj, At, Bt) do { __builtin_amdgcn_s_setprio(1); _Pragma("unroll") for (int m = 0; m < 4; ++m) _Pragma("unroll") for (int n = 0; n < 2; ++n) _Pragma("unroll") for (int k = 0; k < 2; ++k) \
        acc[ai][bj][m][n] = __builtin_amdgcn_mfma_f32_16x16x32_bf16(Bt[n][k], At[m][k], acc[ai][bj][m][n], 0, 0, 0); __builtin_amdgcn_s_setprio(0); } while (0)
#define PG8_WAIT_V(n) asm volatile("s_waitcnt vmcnt(" #n ")" ::: "memory")
#define PG8_WAIT_L(n) asm volatile("s_waitcnt lgkmcnt(" #n ")" ::: "memory")
#define PG8_BAR __builtin_amdgcn_s_barrier()
#define PG8_SCHED __builtin_amdgcn_sched_barrier(0)
    Unit cur, nxt; int ui = 0;
    if (!S.next(0, cur)) return;
    f32x4 acc[2][2][4][2];
    if constexpr (Epi::INIT) E.init(acc, cur, wr, wc, fr, fq);
    else {
#pragma unroll
    for (int a = 0; a < 2; ++a)
#pragma unroll
        for (int b = 0; b < 2; ++b)
#pragma unroll
            for (int m = 0; m < 4; ++m)
#pragma unroll
                for (int n = 0; n < 2; ++n) acc[a][b][m][n] = (f32x4){0.f, 0.f, 0.f, 0.f};
    }
    bf16x8 At[4][2], B0[2][2], B1[2][2];
    const char* cA = (const char*)g.A + (size_t)cur.pm * tstepA; const char* cB = (const char*)g.Bt + (size_t)cur.pn * tstepB;
    PG8_STAGE(PG8_SB(0, 0), cB, voffB); PG8_STAGE(PG8_SA(0, 0), cA, voffA); PG8_STAGE(PG8_SB(0, 1), cB + hstepB, voffB); PG8_STAGE(PG8_SA(0, 1), cA + hstepA, voffA);
    if (wr == 1) PG8_BAR;
    PG8_WAIT_V(4); PG8_BAR;
    PG8_STAGE(PG8_SB(1, 0), cB + kstep, voffB); PG8_STAGE(PG8_SA(1, 0), cA + kstep, voffA); PG8_STAGE(PG8_SB(1, 1), cB + hstepB + kstep, voffB);
    PG8_WAIT_V(6); PG8_BAR;
    if constexpr (Epi::INIT) {
#pragma unroll
        for (int a = 0; a < 2; ++a)
#pragma unroll
            for (int b = 0; b < 2; ++b)
#pragma unroll
                for (int m = 0; m < 4; ++m) asm volatile("" : "+v"(acc[a][b][m][0]), "+v"(acc[a][b][m][1]));
    }
    for (;;) {
        const bool has_next = S.next(ui + 1, nxt);
        const char* nA = has_next ? (const char*)g.A + (size_t)nxt.pm * tstepA : cA; const char* nB = has_next ? (const char*)g.Bt + (size_t)nxt.pn * tstepB : cB;
        for (int t = 0; t < nt; t += 2) {
            const bool last = (t == nt - 2);
            const char* a1 = cA + (size_t)(t + 1) * kstep;
            const char* a2 = last ? nA : cA + (size_t)(t + 2) * kstep; const char* b2 = last ? nB : cB + (size_t)(t + 2) * kstep;
            const char* a3 = a2 + kstep; const char* b3 = b2 + kstep;
            PG8_LDB(B0, 0, 0); PG8_SCHED; PG8_LDA(At, 0, 0); PG8_STAGE(PG8_SA(1, 1), a1 + hstepA, voffA);
            PG8_WAIT_L(8); PG8_BAR; PG8_WAIT_L(0); PG8_MMA(0, 0, At, B0); PG8_BAR; PG8_SCHED;
            PG8_LDB(B1, 0, 1); PG8_STAGE(PG8_SB(0, 0), b2, voffB);
            PG8_BAR; PG8_WAIT_L(0); PG8_MMA(0, 1, At, B1); PG8_BAR;
            PG8_LDA(At, 0, 1); PG8_STAGE(PG8_SA(0, 0), a2, voffA);
            PG8_BAR; PG8_WAIT_L(0); PG8_MMA(1, 0, At, B0); PG8_BAR; PG8_SCHED;
            PG8_STAGE(PG8_SB(0, 1), b2 + hstepB, voffB);
            PG8_WAIT_V(6); PG8_BAR; PG8_MMA(1, 1, At, B1); PG8_BAR;
            PG8_LDB(B0, 1, 0); PG8_SCHED; PG8_LDA(At, 1, 0); PG8_STAGE(PG8_SA(0, 1), a2 + hstepA, voffA);
            PG8_WAIT_L(8); PG8_BAR; PG8_WAIT_L(0); PG8_MMA(0, 0, At, B0); PG8_BAR; PG8_SCHED;
            PG8_LDB(B1, 1, 1); PG8_STAGE(PG8_SB(1, 0), b3, voffB);
            PG8_BAR; PG8_WAIT_L(0); PG8_MMA(0, 1, At, B1); PG8_BAR;
            PG8_LDA(At, 1, 1); PG8_STAGE(PG8_SA(1, 0), a3, voffA);
            PG8_BAR; PG8_WAIT_L(0); PG8_MMA(1, 0, At, B0); PG8_BAR; PG8_SCHED;
            PG8_STAGE(PG8_SB(1, 1), b3 + hstepB, voffB);
            PG8_WAIT_V(6); PG8_BAR; PG8_MMA(1, 1, At, B1); PG8_BAR;
        }
        if constexpr (!Epi::AFTER_DRAIN) { E(acc, cur, ui, wr, wc, fr, fq); }
        if (!has_next) break;
#pragma unroll
        for (int a = 0; a < 2; ++a)
#pragma unroll
            for (int b = 0; b < 2; ++b)
#pragma unroll
                for (int m = 0; m < 4; ++m)
#pragma unroll
                    for (int n = 0; n < 2; ++n) acc[a][b][m][n] = (f32x4){0.f, 0.f, 0.f, 0.f};
        cur = nxt; cA = nA; cB = nB; ++ui;
    }
    PG8_WAIT_V(0);
    if (wr == 0) PG8_BAR;
    PG8_BAR;
    if constexpr (Epi::AFTER_DRAIN) { E.fused(acc, cur, wr, wc, fr, fq, lds, wid, lane); }
#undef PG8_SA
#undef PG8_SB
#undef PG8_STAGE
#undef PG8_LDA
#undef PG8_LDB
#undef PG8_MMA
#undef PG8_WAIT_V
#undef PG8_WAIT_L
#undef PG8_BAR
#undef PG8_SCHED
}

struct EpiBf16Scale {
    static constexpr bool PERM = true, AFTER_DRAIN = false, INIT = false;
    bf16_t* O; int ldc; const float* colscale;
    __device__ __forceinline__ void operator()(const f32x4 (&acc)[2][2][4][2], const Unit& u, int ui, int wr, int wc, int fr, int fq) const {
        const int row0 = u.pm * BM + wr * 64 + fr, col0 = u.pn * BM + wc * 32 + 8 * fq;
        f32x4 sv[2][2];
#pragma unroll
        for (int bj = 0; bj < 2; ++bj)
#pragma unroll
            for (int n = 0; n < 2; ++n) sv[bj][n] = colscale ? *(const f32x4*)(colscale + col0 + bj * HALF + 4 * n) : (f32x4){1.f, 1.f, 1.f, 1.f};
#pragma unroll
        for (int ai = 0; ai < 2; ++ai)
#pragma unroll
            for (int m = 0; m < 4; ++m) { bf16_t* rowp = O + (size_t)(row0 + ai * HALF + m * 16) * ldc + col0;
#pragma unroll
                for (int bj = 0; bj < 2; ++bj) { const f32x4 v0 = acc[ai][bj][m][0] * sv[bj][0], v1 = acc[ai][bj][m][1] * sv[bj][1];
                    u32x4 w; w.x = cvt_pk_bf16(v0[0], v0[1]); w.y = cvt_pk_bf16(v0[2], v0[3]); w.z = cvt_pk_bf16(v1[0], v1[1]); w.w = cvt_pk_bf16(v1[2], v1[3]);
                    *(u32x4*)(rowp + bj * HALF) = w; } }
    }
};
struct EpiSqRelu {
    static constexpr bool PERM = true, AFTER_DRAIN = false, INIT = false;
    bf16_t* O; int ldc; const LAS float* rl;
    __device__ __forceinline__ void operator()(const f32x4 (&acc)[2][2][4][2], const Unit& u, int ui, int wr, int wc, int fr, int fq) const {
        const int row0 = u.pm * BM + wr * 64 + fr, col0 = u.pn * BM + wc * 32 + 8 * fq;
#pragma unroll
        for (int ai = 0; ai < 2; ++ai)
#pragma unroll
            for (int m = 0; m < 4; ++m) { const int rloc = wr * 64 + fr + ai * HALF + m * 16; const int row = u.pm * BM + rloc;
                const float rstd = rl[ui * 256 + rloc];
                bf16_t* rowp = O + (size_t)row * ldc + col0;
#pragma unroll
                for (int bj = 0; bj < 2; ++bj) { f32x4 v0 = acc[ai][bj][m][0] * rstd, v1 = acc[ai][bj][m][1] * rstd;
#pragma unroll
                    for (int j = 0; j < 4; ++j) { const float a = fmaxf(v0[j], 0.f), b = fmaxf(v1[j], 0.f); v0[j] = a * a; v1[j] = b * b; }
                    u32x4 w; w.x = cvt_pk_bf16(v0[0], v0[1]); w.y = cvt_pk_bf16(v0[2], v0[3]); w.z = cvt_pk_bf16(v1[0], v1[1]); w.w = cvt_pk_bf16(v1[2], v1[3]);
                    *(u32x4*)(rowp + bj * HALF) = w; } }
    }
};
struct EpiResid {
    static constexpr bool PERM = false, AFTER_DRAIN = true, INIT = true;
    const float* base; float* out; bf16_t* outb; int ldc; float* ssp;
    __device__ __forceinline__ void init(f32x4 (&acc)[2][2][4][2], const Unit& u, int wr, int wc, int fr, int fq) const {
        const int col0 = u.pn * BM + wc * 32 + 4 * fq;
#pragma unroll
        for (int ai = 0; ai < 2; ++ai)
#pragma unroll
            for (int m = 0; m < 4; ++m) { const size_t off = (size_t)(u.pm * BM + ai * HALF + wr * 64 + m * 16 + fr) * ldc + col0;
#pragma unroll
                for (int bj = 0; bj < 2; ++bj)
#pragma unroll
                    for (int n = 0; n < 2; ++n) acc[ai][bj][m][n] = __builtin_nontemporal_load((const f32x4*)(base + off + bj * HALF + n * 16)); }
    }
    __device__ __forceinline__ void fused(f32x4 (&acc)[2][2][4][2], const Unit& u, int wr, int wc, int fr, int fq, LAS unsigned char* lds, int wid, int lane) const {
        LAS float* P = (LAS float*)lds;
        const int col0 = u.pn * BM + wc * 32 + 4 * fq;
#pragma unroll
        for (int ai = 0; ai < 2; ++ai)
#pragma unroll
            for (int m = 0; m < 4; ++m) { const int r = ai * HALF + wr * 64 + m * 16 + fr; const size_t off = (size_t)(u.pm * BM + r) * ldc + col0; float s = 0.f;
#pragma unroll
                for (int bj = 0; bj < 2; ++bj)
#pragma unroll
                    for (int n = 0; n < 2; ++n) { const f32x4 o = acc[ai][bj][m][n];
                        if (out) *(f32x4*)(out + off + bj * HALF + n * 16) = o;
                        if (outb) { u32x2 w; w.x = cvt_pk_bf16(o[0], o[1]); w.y = cvt_pk_bf16(o[2], o[3]); *(u32x2*)(outb + off + bj * HALF + n * 16) = w; }
                        s += (o[0] * o[0] + o[1] * o[1]) + (o[2] * o[2] + o[3] * o[3]); }
                s += __shfl_xor(s, 16); s += __shfl_xor(s, 32);
                if (fq == 0) P[r * 4 + wc] = s;
                asm volatile("" ::: "memory"); }
        __syncthreads();
        const int tid = wid * 64 + lane;
        if (tid < 256) { const float s = (P[tid * 4 + 0] + P[tid * 4 + 1]) + (P[tid * 4 + 2] + P[tid * 4 + 3]); ssp[(size_t)(u.pm * BM + tid) * 8 + u.pn] = s; }
        __syncthreads();
    }
};

struct EpiFinal {
    static constexpr bool PERM = false, AFTER_DRAIN = true, INIT = true;
    float* out; int ldc; float* ssp; unsigned* cnt; const float* fnw; const bf16_t* hb;
    __device__ __forceinline__ void init(f32x4 (&acc)[2][2][4][2], const Unit& u, int wr, int wc, int fr, int fq) const {
        const int col0 = u.pn * BM + wc * 32 + 4 * fq;
#pragma unroll
        for (int ai = 0; ai < 2; ++ai)
#pragma unroll
            for (int m = 0; m < 4; ++m) { const size_t off = (size_t)(u.pm * BM + ai * HALF + wr * 64 + m * 16 + fr) * ldc + col0;
#pragma unroll
                for (int bj = 0; bj < 2; ++bj)
#pragma unroll
                    for (int n = 0; n < 2; ++n) { const u32x2 w = *(const u32x2*)(hb + off + bj * HALF + n * 16); acc[ai][bj][m][n] = (f32x4){__uint_as_float(w.x << 16), __uint_as_float(w.x & 0xffff0000u), __uint_as_float(w.y << 16), __uint_as_float(w.y & 0xffff0000u)}; } }
    }
    __device__ __forceinline__ void fused(f32x4 (&acc)[2][2][4][2], const Unit& u, int wr, int wc, int fr, int fq, LAS unsigned char* lds, int wid, int lane) const {
        LAS float* P = (LAS float*)lds;
        LAS float* R = (LAS float*)(lds + 4096);
        const int col0 = u.pn * BM + wc * 32 + 4 * fq;
#pragma unroll
        for (int ai = 0; ai < 2; ++ai)
#pragma unroll
            for (int m = 0; m < 4; ++m) { const int r = ai * HALF + wr * 64 + m * 16 + fr; const size_t off = (size_t)(u.pm * BM + r) * ldc + col0; float s = 0.f;
#pragma unroll
                for (int bj = 0; bj < 2; ++bj)
#pragma unroll
                    for (int n = 0; n < 2; ++n) { const f32x4 o = acc[ai][bj][m][n];
                        s += (o[0] * o[0] + o[1] * o[1]) + (o[2] * o[2] + o[3] * o[3]); }
                s += __shfl_xor(s, 16); s += __shfl_xor(s, 32);
                if (fq == 0) P[r * 4 + wc] = s;
                asm volatile("" ::: "memory"); }
        __syncthreads();
        const int tid = wid * 64 + lane;
        float* slot = ssp + (size_t)(u.pm * BM + (tid & 255)) * 8;
        if (tid < 256) { const float s = (P[tid * 4 + 0] + P[tid * 4 + 1]) + (P[tid * 4 + 2] + P[tid * 4 + 3]); __hip_atomic_store(slot + u.pn, s, __ATOMIC_RELAXED, __HIP_MEMORY_SCOPE_AGENT); }
        asm volatile("s_waitcnt vmcnt(0)" ::: "memory");
        __syncthreads();
        if (tid == 0) {
            unsigned* c = cnt + 64 * u.pm;
            __hip_atomic_fetch_add(c, 1u, __ATOMIC_RELAXED, __HIP_MEMORY_SCOPE_AGENT);
            unsigned sp = 0;
            while (__hip_atomic_load(c, __ATOMIC_RELAXED, __HIP_MEMORY_SCOPE_AGENT) < 8u) { __builtin_amdgcn_s_sleep(1); if (++sp > (1u << 24)) break; }
            __builtin_amdgcn_fence(__ATOMIC_ACQUIRE, "agent");
            asm volatile("s_waitcnt vmcnt(0)" ::: "memory");
        }
        __syncthreads();
        if (tid < 256) { float ss = 0.f;
#pragma unroll
            for (int j = 0; j < 8; ++j) ss += __hip_atomic_load(slot + j, __ATOMIC_RELAXED, __HIP_MEMORY_SCOPE_AGENT);
            R[tid] = 1.0f / sqrtf(ss * (1.0f / DM) + EPS); }
        __syncthreads();
#pragma unroll
        for (int ai = 0; ai < 2; ++ai)
#pragma unroll
            for (int m = 0; m < 4; ++m) { const int r = ai * HALF + wr * 64 + m * 16 + fr; const size_t off = (size_t)(u.pm * BM + r) * ldc + col0; const float rs = R[r];
#pragma unroll
                for (int bj = 0; bj < 2; ++bj)
#pragma unroll
                    for (int n = 0; n < 2; ++n) { const f32x4 fw = *(const f32x4*)(fnw + col0 + bj * HALF + n * 16); *(f32x4*)(out + off + bj * HALF + n * 16) = acc[ai][bj][m][n] * rs * fw; } }
    }
};
}

__device__ __forceinline__ int win_map(int n) { return n < 3072 ? n : (n < 3088 ? n + 1024 : n - 16); }
struct P0Desc { const float* src; const float* scale; bf16_t* dst; int ldn, K, n0, N, k0, map, ldk; };
__device__ __forceinline__ P0Desc p0_decode(const Params& p, unsigned char* ws, int it) {
    constexpr int I_1 = 32 * 128, I_2 = 128 * 32, I_IN = 32 * 65, I_OUT = 32 * 32;
    P0Desc d; int r = it, nblk;
    if (r < I_1) { d.src = p.mlp_w1; d.scale = p.norm2_w; d.dst = (bf16_t*)(ws + OFF_W1T); d.ldn = DFF; d.K = DM; d.N = DFF; d.map = 0; nblk = 128; }
    else if ((r -= I_1) < I_2) { d.src = p.mlp_w2; d.scale = nullptr; d.dst = (bf16_t*)(ws + OFF_W2T); d.ldn = DM; d.K = DFF; d.N = DM; d.map = 0; nblk = 32; }
    else if ((r -= I_2) < I_IN) { d.src = p.w_in; d.scale = p.norm1_w; d.dst = (bf16_t*)(ws + OFF_WINT); d.ldn = DIN; d.K = DM; d.N = DIN; d.map = 1; nblk = 65; }
    else if ((r -= I_IN) < I_OUT) { d.src = p.w_out; d.scale = nullptr; d.dst = (bf16_t*)(ws + OFF_WOUTT); d.ldn = DM; d.K = DM; d.N = DM; d.map = 0; nblk = 32; }
    else { r -= I_OUT; const int g = r >> 4; r &= 15; d.src = p.pool_w + (size_t)g * 65536; d.scale = nullptr; d.dst = (bf16_t*)(ws + OFF_POOLWT) + (size_t)g * 65536; d.ldn = 256; d.K = 256; d.N = 256; d.map = 0; nblk = 4; }
    d.ldk = d.map ? XLD : d.K;
    const int nkb = d.K >> 6; const int nb = r / nkb, kb = r - nb * nkb; d.k0 = kb * 64; d.n0 = nb * 64;
    return d;
}
#define P0_LOAD(d, v) do { const int _n = (d).n0 + lane; const float* _s = (d).src + (size_t)(d).k0 * (d).ldn + (_n < (d).N ? _n : 0); \
    _Pragma("unroll") for (int _i = 0; _i < 64; ++_i) v[_i] = __builtin_nontemporal_load(_s + (size_t)_i * (d).ldn); } while (0)
__device__ __forceinline__ void p0_rows2(const float* r0, const float* r1, bf16_t* o0, bf16_t* o1, bool two, int lane) {
    const f32x4* x0 = (const f32x4*)r0 + lane; const f32x4* x1 = (const f32x4*)r1 + lane; f32x4 v[8], w[8]; float s0 = 0.f, s1 = 0.f;
#pragma unroll
    for (int j = 0; j < 8; ++j) v[j] = __builtin_nontemporal_load(x0 + 64 * j);
    if (two) {
#pragma unroll
        for (int j = 0; j < 8; ++j) w[j] = __builtin_nontemporal_load(x1 + 64 * j);
    } else {
#pragma unroll
        for (int j = 0; j < 8; ++j) w[j] = (f32x4){0.f, 0.f, 0.f, 0.f};
    }
#pragma unroll
    for (int j = 0; j < 8; ++j) { s0 += (v[j][0] * v[j][0] + v[j][1] * v[j][1]) + (v[j][2] * v[j][2] + v[j][3] * v[j][3]); s1 += (w[j][0] * w[j][0] + w[j][1] * w[j][1]) + (w[j][2] * w[j][2] + w[j][3] * w[j][3]); }
    const float rs0 = 1.0f / sqrtf(wave_sum(s0) * (1.0f / DM) + EPS), rs1 = 1.0f / sqrtf(wave_sum(s1) * (1.0f / DM) + EPS);
    u32x2* q0 = (u32x2*)o0 + lane; u32x2* q1 = (u32x2*)o1 + lane;
#pragma unroll
    for (int j = 0; j < 8; ++j) { u32x2 t; t.x = cvt_pk_bf16(v[j][0] * rs0, v[j][1] * rs0); t.y = cvt_pk_bf16(v[j][2] * rs0, v[j][3] * rs0); q0[64 * j] = t; }
    if (two) {
#pragma unroll
        for (int j = 0; j < 8; ++j) { u32x2 t; t.x = cvt_pk_bf16(w[j][0] * rs1, w[j][1] * rs1); t.y = cvt_pk_bf16(w[j][2] * rs1, w[j][3] * rs1); q1[64 * j] = t; }
    }
}
__device__ __forceinline__ void phase0(const Params& p, unsigned char* lds) {
    const int tid = opaque_tid(), lane = tid & 63, wave = tid >> 6;
    LAS float* scr = (LAS float*)((LAS unsigned char*)lds + wave * 16640);
    const int gw = blockIdx.x * 8 + wave, NGW = NBLK * 8;
    unsigned char* ws = p.ws;
    constexpr int NITEMS = 32 * 128 + 128 * 32 + 32 * 65 + 32 * 32 + 4 * 16;
    float v[64];
    int it = (int)(((long)gw * NITEMS) / NGW); const int it_end = (int)(((long)(gw + 1) * NITEMS) / NGW);
    P0Desc d = p0_decode(p, ws, it < it_end ? it : 0);
    if (it < it_end) P0_LOAD(d, v);
    while (it < it_end) {
        const bool ok = d.n0 + lane < d.N;
#pragma unroll
        for (int i = 0; i < 64; ++i) { const float sc = d.scale ? d.scale[d.k0 + i] : 1.0f; scr[i * 65 + lane] = ok ? v[i] * sc : 0.f; }
        asm volatile("s_waitcnt lgkmcnt(0)" ::: "memory"); __builtin_amdgcn_wave_barrier();
        const P0Desc c = d;
        it += 1;
        if (it < it_end) { d = p0_decode(p, ws, it); P0_LOAD(d, v); }
#pragma unroll
        for (int j = 0; j < 8; ++j) { const int pc = lane + 64 * j, nn = pc >> 3, cc = pc & 7; const LAS float* s = scr + (8 * cc) * 65 + nn;
            u32x4 o; o.x = cvt_pk_bf16(s[0], s[65]); o.y = cvt_pk_bf16(s[2 * 65], s[3 * 65]); o.z = cvt_pk_bf16(s[4 * 65], s[5 * 65]); o.w = cvt_pk_bf16(s[6 * 65], s[7 * 65]);
            const int ng = c.n0 + nn;
            if (ng < c.N) { const int row = c.map ? win_map(ng) : ng; *(u32x4*)(c.dst + (size_t)row * c.ldk + c.k0 + 8 * cc) = o; } }
        asm volatile("s_waitcnt lgkmcnt(0)" ::: "memory"); __builtin_amdgcn_wave_barrier();
    }
    {
        bf16_t* xb = (bf16_t*)(ws + OFF_XB);
        const int r0 = 1024 * (blockIdx.x & 7) + ((blockIdx.x >> 3) * 8 + wave);
#pragma unroll 1
        for (int i = 0; i < 4; i += 2) { const int m = r0 + 256 * i, m2 = m + 256;
            p0_rows2(p.x + (size_t)m * DM, p.x + (size_t)m2 * DM, xb + (size_t)m * XLD, xb + (size_t)m2 * XLD, true, lane); }
        if (gw < NMETA) { const float* sm = p.meta + (size_t)gw * DM; bf16_t* om = xb + (size_t)(MR + gw) * XLD; p0_rows2(sm, sm, om, om, false, lane); }
    }
}

__device__ __forceinline__ void phase1_skinny(const Params& p, unsigned char* lds) {
    const int tid = opaque_tid(), lane = tid & 63, wave = tid >> 6;
    unsigned char* ws = p.ws;
    const bf16_t* xb = (const bf16_t*)(ws + OFF_XB); const bf16_t* wint = (const bf16_t*)(ws + OFF_WINT);
    f32x4* red = (f32x4*)lds;
#pragma unroll 1
    for (int task = blockIdx.x; task < 513 + 256; task += NBLK) {
        const bf16_t* Mrows = task < 513 ? xb + (size_t)task * 16 * XLD : xb + (size_t)MR * XLD;
        const bf16_t* Nrows = task < 513 ? wint + (size_t)4096 * XLD : wint + (size_t)(task - 513) * 16 * XLD;
        const bf16x8* mp = (const bf16x8*)(Mrows + (size_t)(lane & 15) * XLD + wave * 256 + 8 * (lane >> 4));
        const bf16x8* np = (const bf16x8*)(Nrows + (size_t)(lane & 15) * XLD + wave * 256 + 8 * (lane >> 4));
        bf16x8 mf[8], nf[8];
#pragma unroll
        for (int kk = 0; kk < 8; ++kk) { mf[kk] = mp[kk * 4]; nf[kk] = np[kk * 4]; }
        f32x4 a = {0.f, 0.f, 0.f, 0.f};
#pragma unroll
        for (int kk = 0; kk < 8; ++kk) a = mfma16(nf[kk], mf[kk], a);
        red[wave * 64 + lane] = a;
        lds_barrier();
        if (wave == 0) {
            f32x4 sacc = red[lane];
#pragma unroll
            for (int w = 1; w < 8; ++w) sacc += red[w * 64 + lane];
            if (task < 513) *(f32x4*)((float*)(ws + OFF_GLR) + (size_t)(task * 16 + (lane & 15)) * 16 + 4 * (lane >> 4)) = sacc;
            else { u32x2 w; w.x = cvt_pk_bf16(sacc[0], sacc[1]); w.y = cvt_pk_bf16(sacc[2], sacc[3]);
                *(u32x2*)((bf16_t*)(ws + OFF_PROJ) + (size_t)(MR + (lane & 15)) * PLD + (task - 513) * 16 + 4 * (lane >> 4)) = w; }
        }
        lds_barrier();
    }
}

constexpr int L_GLR = 0, L_W2 = 4096, L_GSUM = 12288, L_QD = 14336, L_KI = 31744, L_KET = 49152, L_VT = 67584, L_P = 104448;
struct GlaIn { bf16_t qv[16], kv[16], vv[32]; f32x4 glrv, w2v; float gb; };
__device__ __forceinline__ void gla_a_load(const Params& p, int u, GlaIn& r) {
    const int tid = opaque_tid();
    unsigned char* ws = p.ws;
    const bool meta = u >= 512;
    const int h = meta ? (u - 512) : ((u >> 5) & 3);
    const int row0 = meta ? MR : ((u >> 7) * 2048 + (u & 31) * 64);
    const int nvalid = meta ? NMETA : 64;
    const bf16_t* proj = (const bf16_t*)(ws + OFF_PROJ);
    const float* glr = (const float*)(ws + OFF_GLR);
    const int d = tid & 127, tq = tid >> 7, dvc = tid & 255, th = tid >> 8;
#pragma unroll
    for (int i = 0; i < 16; ++i) { const int t = tq * 16 + i, tc = t < nvalid ? t : nvalid - 1; const bf16_t* pr = proj + (size_t)(row0 + tc) * PLD + h * 128 + d; r.qv[i] = pr[0]; r.kv[i] = pr[512]; }
#pragma unroll
    for (int i = 0; i < 32; ++i) { const int t = th * 32 + i, tc = t < nvalid ? t : nvalid - 1; r.vv[i] = proj[(size_t)(row0 + tc) * PLD + 1024 + h * 256 + dvc]; }
    r.gb = p.gate_b[h * 128 + d];
    { const int rr = (tid & 255) >> 2, part = tid & 3, rc = rr < nvalid ? rr : nvalid - 1; r.glrv = *(const f32x4*)(glr + (size_t)(row0 + rc) * 16 + part * 4); }
    { const int idx = tid * 4, j = idx >> 7, dd = idx & 127; r.w2v = *(const f32x4*)(p.gate_w2 + j * 512 + h * 128 + dd); }
}
__device__ __forceinline__ void gla_a_compute(const Params& p, unsigned char* lds, int u, const GlaIn& r) {
    const int tid = opaque_tid(), lane = tid & 63, wave = tid >> 6, fr = lane & 15, fq = lane >> 4;
    unsigned char* ws = p.ws;
    const bool meta = u >= 512;
    const int h = meta ? (u - 512) : ((u >> 5) & 3);
    const int row0 = meta ? MR : ((u >> 7) * 2048 + (u & 31) * 64);
    const int nvalid = meta ? NMETA : 64;
    bf16_t* proj = (bf16_t*)(ws + OFF_PROJ);
    float* glr_s = (float*)(lds + L_GLR); float* w2_s = (float*)(lds + L_W2); float* gsum = (float*)(lds + L_GSUM);
    bf16_t* qd_s = (bf16_t*)(lds + L_QD); bf16_t* ki_s = (bf16_t*)(lds + L_KI); bf16_t* ket_s = (bf16_t*)(lds + L_KET); bf16_t* vt_s = (bf16_t*)(lds + L_VT);
    const int d = tid & 127, tq = tid >> 7, dvc = tid & 255, th = tid >> 8;
    const float gb = r.gb;
    if (tid < 256) { const int rr = tid >> 2, part = tid & 3; *(f32x4*)(glr_s + rr * 16 + part * 4) = rr < nvalid ? r.glrv : (f32x4){0.f, 0.f, 0.f, 0.f}; }
    *(f32x4*)(w2_s + tid * 4) = r.w2v;
    lds_barrier();
    {
        float w2c[16];
#pragma unroll
        for (int j = 0; j < 16; ++j) w2c[j] = w2_s[j * 128 + d];
        float G[16]; float run = 0.f;
#pragma unroll
        for (int i = 0; i < 16; ++i) { const int t = tq * 16 + i; const float* gr = glr_s + t * 16; float g = gb;
#pragma unroll
            for (int j = 0; j < 16; ++j) g += gr[j] * w2c[j];
            float lg = (fminf(g, 0.f) - __logf(1.0f + __expf(-fabsf(g)))) * (1.0f / 16.0f);
            if (t >= nvalid) lg = 0.f;
            run += lg; G[i] = run; }
        gsum[tq * 128 + d] = run;
        lds_barrier();
        float off = 0.f, tot = 0.f;
#pragma unroll
        for (int q = 0; q < 4; ++q) { const float sg = gsum[q * 128 + d]; tot += sg; if (q < tq) off += sg; }
#pragma unroll
        for (int i = 0; i < 16; ++i) { const int t = tq * 16 + i; const float Gt = off + G[i];
            const float q = t < nvalid ? bf2f(r.qv[i]) : 0.f, k = t < nvalid ? bf2f(r.kv[i]) : 0.f;
            const bf16_t qdb = f2bf(q * 0.08838834764831845f * __expf(Gt));
            qd_s[t * 136 + d] = qdb; ki_s[t * 136 + d] = f2bf(k * __expf(-Gt)); ket_s[d * 72 + t] = f2bf(k * __expf(tot - Gt));
            if (!meta) proj[(size_t)(row0 + t) * PLD + h * 128 + d] = qdb; }
        if (tq == 0) ((float*)(ws + OFF_DECAY))[u * 128 + d] = __expf(tot);
    }
#pragma unroll
    for (int i = 0; i < 32; ++i) { const int t = th * 32 + i; vt_s[dvc * 72 + t] = t < nvalid ? r.vv[i] : (bf16_t)0; }
    lds_barrier();
    if (!meta) {
#pragma unroll
        for (int ii = 0; ii < 2; ++ii) { const int idx = 2 * wave + ii, tt = idx >> 2, ss = idx & 3; f32x4 acc = {0.f, 0.f, 0.f, 0.f};
            if (ss <= tt) {
#pragma unroll
                for (int kk = 0; kk < 4; ++kk) { const bf16x8 mf = *(const bf16x8*)(lds + L_QD + (tt * 16 + fr) * 272 + (kk * 32 + 8 * fq) * 2);
                    const bf16x8 nf = *(const bf16x8*)(lds + L_KI + (ss * 16 + fr) * 272 + (kk * 32 + 8 * fq) * 2); acc = mfma16(nf, mf, acc); } }
            const int t = tt * 16 + fr, s0 = ss * 16 + 4 * fq;
#pragma unroll
            for (int j = 0; j < 4; ++j) if (s0 + j > t) acc[j] = 0.f;
            u32x2 w; w.x = cvt_pk_bf16(acc[0], acc[1]); w.y = cvt_pk_bf16(acc[2], acc[3]);
            *(u32x2*)(lds + L_P + t * 144 + s0 * 2) = w; }
    }
    lds_barrier();
    if (!meta) {
        f32x4 o[4][2];
#pragma unroll
        for (int tt = 0; tt < 4; ++tt) { o[tt][0] = (f32x4){0.f, 0.f, 0.f, 0.f}; o[tt][1] = (f32x4){0.f, 0.f, 0.f, 0.f}; }
#pragma unroll
        for (int kk = 0; kk < 2; ++kk) { bf16x8 nf[2];
#pragma unroll
            for (int dd = 0; dd < 2; ++dd) nf[dd] = *(const bf16x8*)(lds + L_VT + (wave * 32 + dd * 16 + fr) * 144 + (kk * 32 + 8 * fq) * 2);
#pragma unroll
            for (int tt = 0; tt < 4; ++tt) { const bf16x8 mf = *(const bf16x8*)(lds + L_P + (tt * 16 + fr) * 144 + (kk * 32 + 8 * fq) * 2);
                o[tt][0] = mfma16(nf[0], mf, o[tt][0]); o[tt][1] = mfma16(nf[1], mf, o[tt][1]); } }
        u32x2* dump = (u32x2*)(ws + OFF_OINTRA) + ((size_t)(u * 8 + wave) * 8) * 64 + lane;
#pragma unroll
        for (int tt = 0; tt < 4; ++tt)
#pragma unroll
            for (int dd = 0; dd < 2; ++dd) { u32x2 w; w.x = cvt_pk_bf16(o[tt][dd][0], o[tt][dd][1]); w.y = cvt_pk_bf16(o[tt][dd][2], o[tt][dd][3]); dump[(tt * 2 + dd) * 64] = w; }
    }
    {
        bf16_t* dsb = meta ? (bf16_t*)(ws + OFF_DSMETA) + (size_t)h * 32768 : (bf16_t*)p.out + (size_t)u * 32768;
#pragma unroll
        for (int dvt = 0; dvt < 2; ++dvt) { f32x4 acc[8];
#pragma unroll
            for (int i = 0; i < 8; ++i) acc[i] = (f32x4){0.f, 0.f, 0.f, 0.f};
#pragma unroll
            for (int kk = 0; kk < 2; ++kk) { const bf16x8 mf = *(const bf16x8*)(lds + L_VT + (wave * 32 + dvt * 16 + fr) * 144 + (kk * 32 + 8 * fq) * 2);
#pragma unroll
                for (int dkt = 0; dkt < 8; ++dkt) { const bf16x8 nf = *(const bf16x8*)(lds + L_KET + (dkt * 16 + fr) * 144 + (kk * 32 + 8 * fq) * 2); acc[dkt] = mfma16(nf, mf, acc[dkt]); } }
            bf16_t* dst = dsb + (size_t)(wave * 32 + dvt * 16 + fr) * 128 + 4 * fq;
#pragma unroll
            for (int dkt = 0; dkt < 8; ++dkt) { u32x2 w; w.x = cvt_pk_bf16(acc[dkt][0], acc[dkt][1]); w.y = cvt_pk_bf16(acc[dkt][2], acc[dkt][3]); *(u32x2*)(dst + dkt * 16) = w; } }
    }
    lds_barrier();
}
template <int W>
__device__ __forceinline__ void pool_y_rows(const bf16_t* __restrict__ proj, bf16_t* __restrict__ mixed, int b, int t0, int ch0) {
    u32x4 rows[8 + W];
#pragma unroll
    for (int i = 0; i < 8 + W; ++i) { const int tt = t0 - W + i; const size_t row = tt >= 0 ? (size_t)b * 2048 + tt : (size_t)(MR + NMETA + tt);
        rows[i] = *(const u32x4*)(proj + row * PLD + 3072 + ch0); }
    float sum[8];
#pragma unroll
    for (int e = 0; e < 8; ++e) sum[e] = 0.f;
#define POOL_UNPK(v, dst) do { dst[0] = __uint_as_float((v).x << 16); dst[1] = __uint_as_float((v).x & 0xffff0000u); dst[2] = __uint_as_float((v).y << 16); dst[3] = __uint_as_float((v).y & 0xffff0000u); \
        dst[4] = __uint_as_float((v).z << 16); dst[5] = __uint_as_float((v).z & 0xffff0000u); dst[6] = __uint_as_float((v).w << 16); dst[7] = __uint_as_float((v).w & 0xffff0000u); } while (0)
#pragma unroll
    for (int i = 1; i < W; ++i) { float v[8]; POOL_UNPK(rows[i], v);
#pragma unroll
        for (int e = 0; e < 8; ++e) sum[e] += v[e]; }
    constexpr float inv = 1.0f / (float)W;
#pragma unroll
    for (int i = 0; i < 8; ++i) { float nv[8]; POOL_UNPK(rows[W + i], nv);
        float y[8];
#pragma unroll
        for (int e = 0; e < 8; ++e) { sum[e] += nv[e]; y[e] = sum[e] * inv - nv[e]; }
        float ov[8]; POOL_UNPK(rows[i + 1], ov);
#pragma unroll
        for (int e = 0; e < 8; ++e) sum[e] -= ov[e];
        u32x4 o; o.x = cvt_pk_bf16(y[0], y[1]); o.y = cvt_pk_bf16(y[2], y[3]); o.z = cvt_pk_bf16(y[4], y[5]); o.w = cvt_pk_bf16(y[6], y[7]);
        *(u32x4*)(mixed + ((size_t)b * 2048 + t0 + i) * DM + ch0) = o; }
#undef POOL_UNPK
}
__device__ __forceinline__ void pool_y_task(const Params& p, int task) {
    const int tid = opaque_tid(), lane = tid & 63, wave = tid >> 6, g = wave >> 1;
    const int ch0 = g * 256 + (lane & 31) * 8;
    const int b = task >> 6, t0 = (task & 63) * 32 + (wave & 1) * 16 + (lane >> 5) * 8;
    const bf16_t* proj = (const bf16_t*)(p.ws + OFF_PROJ); bf16_t* mixed = (bf16_t*)(p.ws + OFF_MIXED);
    if (g == 0) pool_y_rows<2>(proj, mixed, b, t0, ch0);
    else if (g == 1) pool_y_rows<4>(proj, mixed, b, t0, ch0);
    else if (g == 2) pool_y_rows<8>(proj, mixed, b, t0, ch0);
    else pool_y_rows<16>(proj, mixed, b, t0, ch0);
}

__device__ __forceinline__ void gla_scan(const Params& p, const int e) {
    unsigned char* ws = p.ws;
    const int bh = e >> 13, rem = e & 8191, h = bh & 3;
    const size_t eo = (size_t)rem * 4;
    const int dk4 = (rem & 31) * 4;
    const u32x2 sm0 = *(const u32x2*)((const bf16_t*)(ws + OFF_DSMETA) + (size_t)h * 32768 + eo);
    f32x4 S = {__uint_as_float(sm0.x << 16), __uint_as_float(sm0.x & 0xffff0000u), __uint_as_float(sm0.y << 16), __uint_as_float(sm0.y & 0xffff0000u)};
    const bf16_t* ds = (const bf16_t*)p.out + (size_t)bh * 32 * 32768 + eo;
    const float* dec = (const float*)(ws + OFF_DECAY) + (size_t)bh * 32 * 128 + dk4;
    bf16_t* sp = (bf16_t*)(ws + OFF_SPREV) + (size_t)bh * 31 * 32768 + eo;
    bf16_t* sm = (bf16_t*)(ws + OFF_SMETAB) + (size_t)h * 32768 + eo;
    u32x2 d0[8], d1[8]; f32x4 a0[8], a1[8];
#define SCAN_LD(db, ab, c0) do { _Pragma("unroll") for (int _j = 0; _j < 8; ++_j) { db[_j] = *(const u32x2*)(ds + (size_t)((c0) + _j) * 32768); ab[_j] = *(const f32x4*)(dec + ((c0) + _j) * 128); } } while (0)
#define SCAN_DO(db, ab, c0) do { _Pragma("unroll") for (int _j = 0; _j < 8; ++_j) { const int _c = (c0) + _j; u32x2 _w; _w.x = cvt_pk_bf16(S[0], S[1]); _w.y = cvt_pk_bf16(S[2], S[3]); \
        if (_c == 0) { if (bh < 4) *(u32x2*)sm = _w; } else *(u32x2*)(sp + (size_t)(_c - 1) * 32768) = _w; \
        const f32x4 _d = {__uint_as_float(db[_j].x << 16), __uint_as_float(db[_j].x & 0xffff0000u), __uint_as_float(db[_j].y << 16), __uint_as_float(db[_j].y & 0xffff0000u)}; \
        S = ab[_j] * S + _d; } } while (0)
    SCAN_LD(d0, a0, 0); SCAN_LD(d1, a1, 8);
    SCAN_DO(d0, a0, 0); SCAN_LD(d0, a0, 16);
    SCAN_DO(d1, a1, 8); SCAN_LD(d1, a1, 24);
    SCAN_DO(d0, a0, 16);
    SCAN_DO(d1, a1, 24);
#undef SCAN_LD
#undef SCAN_DO
}

__device__ __forceinline__ void gla_c_unit(const Params& p, unsigned char* lds, int u) {
    const int tid = opaque_tid(), lane = tid & 63, wave = tid >> 6, fr = lane & 15, fq = lane >> 4;
    unsigned char* ws = p.ws;
    const int h = (u >> 5) & 3, row0 = (u >> 7) * 2048 + (u & 31) * 64;
    const bf16_t* proj = (const bf16_t*)(ws + OFF_PROJ);
    f32x4 o[4][2];
    const u32x2* dump = (const u32x2*)(ws + OFF_OINTRA) + ((size_t)(u * 8 + wave) * 8) * 64 + lane;
    const bf16_t* qbase = proj + (size_t)(row0 + fr) * PLD + h * 128 + 8 * fq;
    const int cch = u & 31, bhh = u >> 5;
    const bf16_t* sbase = (cch == 0 ? (const bf16_t*)(ws + OFF_SMETAB) + (size_t)h * 32768 : (const bf16_t*)(ws + OFF_SPREV) + (size_t)(bhh * 31 + cch - 1) * 32768) + (size_t)(wave * 32 + fr) * 128 + 8 * fq;
    bf16x8 nf[4][2], mf[4][4]; u32x2 rr[4][2]; f32x4 nw[2];
#pragma unroll
    for (int kk = 0; kk < 4; ++kk) {
#pragma unroll
        for (int dd = 0; dd < 2; ++dd) nf[kk][dd] = *(const bf16x8*)(sbase + dd * 16 * 128 + kk * 32);
#pragma unroll
        for (int tt = 0; tt < 4; ++tt) mf[kk][tt] = *(const bf16x8*)(qbase + (size_t)tt * 16 * PLD + kk * 32); }
#pragma unroll
    for (int tt = 0; tt < 4; ++tt)
#pragma unroll
        for (int dd = 0; dd < 2; ++dd) { const u32x2 w = dump[(tt * 2 + dd) * 64]; o[tt][dd] = (f32x4){__uint_as_float(w.x << 16), __uint_as_float(w.x & 0xffff0000u), __uint_as_float(w.y << 16), __uint_as_float(w.y & 0xffff0000u)}; }
#pragma unroll
    for (int tt = 0; tt < 4; ++tt)
#pragma unroll
        for (int dd = 0; dd < 2; ++dd) rr[tt][dd] = *(const u32x2*)(proj + (size_t)(row0 + tt * 16 + fr) * PLD + 2048 + h * 256 + wave * 32 + dd * 16 + 4 * fq);
#pragma unroll
    for (int dd = 0; dd < 2; ++dd) nw[dd] = *(const f32x4*)(p.gla_norm_w + wave * 32 + dd * 16 + 4 * fq);
#pragma unroll
    for (int kk = 0; kk < 4; ++kk)
#pragma unroll
        for (int tt = 0; tt < 4; ++tt) { o[tt][0] = mfma16(nf[kk][0], mf[kk][tt], o[tt][0]); o[tt][1] = mfma16(nf[kk][1], mf[kk][tt], o[tt][1]); }
    float* ssq = (float*)lds;
#pragma unroll
    for (int tt = 0; tt < 4; ++tt) { float s = 0.f;
#pragma unroll
        for (int dd = 0; dd < 2; ++dd) s += (o[tt][dd][0] * o[tt][dd][0] + o[tt][dd][1] * o[tt][dd][1]) + (o[tt][dd][2] * o[tt][dd][2] + o[tt][dd][3] * o[tt][dd][3]);
        s += __shfl_xor(s, 16); s += __shfl_xor(s, 32);
        if (fq == 0) ssq[(tt * 16 + fr) * 8 + wave] = s; }
    lds_barrier();
    bf16_t* mixed = (bf16_t*)(ws + OFF_MIXED);
#pragma unroll
    for (int tt = 0; tt < 4; ++tt) { const int t = tt * 16 + fr;
        const f32x4 a = *(const f32x4*)(ssq + t * 8), b = *(const f32x4*)(ssq + t * 8 + 4);
        const float tot = ((a[0] + a[1]) + (a[2] + a[3])) + ((b[0] + b[1]) + (b[2] + b[3]));
        const float rstd = 1.0f / sqrtf(tot * (1.0f / 256.0f) + EPS);
#pragma unroll
        for (int dd = 0; dd < 2; ++dd) { const int dv = wave * 32 + dd * 16 + 4 * fq;
            const u32x2 rv = rr[tt][dd];
            float r[4] = {__uint_as_float(rv.x << 16), __uint_as_float(rv.x & 0xffff0000u), __uint_as_float(rv.y << 16), __uint_as_float(rv.y & 0xffff0000u)};
            float y[4];
#pragma unroll
            for (int j = 0; j < 4; ++j) y[j] = o[tt][dd][j] * rstd * nw[dd][j] * (r[j] / (1.0f + __expf(-r[j])));
            u32x2 w; w.x = cvt_pk_bf16(y[0], y[1]); w.y = cvt_pk_bf16(y[2], y[3]);
            *(u32x2*)(mixed + (size_t)(row0 + t) * DM + h * 256 + dv) = w; } }
    lds_barrier();
}

__device__ __forceinline__ void phase6(const Params& p) {
    const int tid = opaque_tid(), lane = tid & 63, wave = tid >> 6, gw = blockIdx.x * 8 + wave;
    const float* ssp = (const float*)(p.ws + OFF_SS3P);
    f32x4 fw[8];
#pragma unroll
    for (int j = 0; j < 8; ++j) fw[j] = ((const f32x4*)p.final_norm_w)[lane + 64 * j];
    for (int m = gw; m < MR; m += NBLK * 8) {
        const f32x4 p0 = *(const f32x4*)(ssp + (size_t)m * 8), p1 = *(const f32x4*)(ssp + (size_t)m * 8 + 4);
        const float ss = ((p0[0] + p0[1]) + (p0[2] + p0[3])) + ((p1[0] + p1[1]) + (p1[2] + p1[3]));
        const float rstd = 1.0f / sqrtf(ss * (1.0f / DM) + EPS);
        f32x4* row = (f32x4*)(p.out + (size_t)m * DM) + lane;
#pragma unroll
        for (int j = 0; j < 8; ++j) { f32x4 v = row[64 * j]; row[64 * j] = v * rstd * fw[j]; }
    }
}

__global__ void __launch_bounds__(NTHR, 2) hybrid_fwd(Params p) {
    extern __shared__ __attribute__((aligned(16))) unsigned char lds[];
    cg::grid_group grid = cg::this_grid();
    LAS unsigned char* ldsl = (LAS unsigned char*)lds;
    unsigned char* ws = p.ws;
    const int bx = blockIdx.x;
    const int xl = bx & 7, rk = bx >> 3;
    const int uA = (xl >> 1) * 128 + (2 * (rk >> 4)) * 32 + 16 * (xl & 1) + (rk & 15), uB = uA + 32;
    const int ptask = (xl >> 1) * 64 + (xl & 1) * 32 + rk;
    const int ptask_lo = (((bx - 4) & 7) >> 1) * 64 + (((bx - 4) & 7) & 1) * 32 + ((bx - 4) >> 3);

    volatile LAS unsigned* xst = (volatile LAS unsigned*)(ldsl + LDS_BYTES - 16);
    if (threadIdx.x < 4) xst[threadIdx.x] = 0u;
    unsigned* barw = (unsigned*)(ws + OFF_BAR);
    __syncthreads();
    XcdBarrier xb = xcd_barrier_post(barw, xst);
    if (p.stop == 0x7fffffff) grid.sync();

    phase0(p, lds);
    GSYNC();
#pragma unroll 1
    for (int _q = 1; _q < REP_P0; ++_q) { phase0(p, lds); GSYNC(); }

#pragma unroll 1
    for (int _q = 0; _q < REP_P1; ++_q) {
    phase1_skinny(p, lds);
    __syncthreads();
    {
        pg8::Gemm g{(const bf16_t*)(ws + OFF_XB), (const bf16_t*)(ws + OFF_WINT), MR, NPROJ, DM, XLD, XLD};
        pg8::StaticOrder S; S.init(MR, NPROJ, NBLK, bx);
        pg8::EpiBf16Scale E{(bf16_t*)(ws + OFF_PROJ), PLD, nullptr};
        pg8::gemm_phase<pg8::EpiBf16Scale>(ldsl, g, S, E);
    }
    GSYNC();
    }
    STOP_AT(1);

#if PROBE_STOP
    if (p.pad) { const int var = p.pad; GlaIn ra;
        if (!(var & 8)) { if (bx < 4 && !(var & 2)) { gla_a_load(p, 512 + bx, ra); gla_a_compute(p, lds, 512 + bx, ra); }
            gla_a_load(p, bx, ra); gla_a_compute(p, lds, bx, ra);
            if (!(var & 4)) { gla_a_load(p, bx + NBLK, ra); gla_a_compute(p, lds, bx + NBLK, ra); } }
        if (!(var & 1)) { if (bx >= 4) pool_y_task(p, bx); if (bx >= 4 && bx < 8) pool_y_task(p, bx - 4); }
    } else
#endif
    {
    {
        GlaIn ra, rb;
        if (bx < 4) { gla_a_load(p, 512 + bx, ra); gla_a_load(p, uA, rb); gla_a_compute(p, lds, 512 + bx, ra); gla_a_load(p, uB, ra); gla_a_compute(p, lds, uA, rb); gla_a_compute(p, lds, uB, ra); }
        else { gla_a_load(p, uA, ra); gla_a_load(p, uB, rb); gla_a_compute(p, lds, uA, ra); gla_a_compute(p, lds, uB, rb); }
    }
    if (bx >= 4) pool_y_task(p, ptask);
    if (bx >= 4 && bx < 8) pool_y_task(p, ptask_lo);
    }
    GSYNC();
    STOP_AT(2);

#pragma unroll 1
    for (int _q = 0; _q < REP_P2BC; ++_q) {
    if (bx < 128 && _q == 0) {
        const int gq = bx >> 5;
        pg8::Gemm g{(const bf16_t*)(ws + OFF_MIXED) + gq * 256, (const bf16_t*)(ws + OFF_POOLWT) + (size_t)gq * 65536, MR, 256, 256, DM, 256};
        pg8::StaticOrder S; S.init(MR, 256, 32, bx & 31);
        pg8::EpiBf16Scale E{(bf16_t*)(ws + OFF_MIXED) + 1024 + gq * 256, DM, p.pool_scale + gq * 256};
        pg8::gemm_phase<pg8::EpiBf16Scale>(ldsl, g, S, E);
    } else {
        const int li = ((bx >> 3) - 16) * 2 + (bx & 1);
        const int e0 = ((bx & 7) >> 1) * 32768 + li * NTHR + opaque_tid();
        gla_scan(p, e0);
        gla_scan(p, e0 + 16384);
    }
    GSYNC();
    STOP_AT(3);

    gla_c_unit(p, lds, uA); gla_c_unit(p, lds, uB);
    GSYNC();
    }
    STOP_AT(4);

#pragma unroll 1
    for (int _q = 0; _q < REP_P3; ++_q) {
    {
        pg8::Gemm g{(const bf16_t*)(ws + OFF_MIXED), (const bf16_t*)(ws + OFF_WOUTT), MR, DM, DM, DM, DM};
        pg8::StaticOrder S; S.init(MR, DM, NBLK, bx);
        pg8::EpiResid E{p.x, nullptr, (bf16_t*)(ws + OFF_H2B), DM, (float*)(ws + OFF_SS2P)};
        pg8::gemm_phase<pg8::EpiResid>(ldsl, g, S, E);
    }
    GSYNC();
    }
    STOP_AT(5);

#pragma unroll 1
    for (int _q = 0; _q < REP_P4; ++_q) {
    {
        pg8::Gemm g{(const bf16_t*)(ws + OFF_H2B), (const bf16_t*)(ws + OFF_W1T), MR, DFF, DM, DM, DM};
        pg8::StaticOrder S; S.init(MR, DFF, NBLK, bx);
        LAS float* rl = (LAS float*)(ldsl + pg8::STAGE_BYTES);
        { const int t = opaque_tid(); const float* ssp = (const float*)(ws + OFF_SS2P);
#pragma unroll 1
          for (int i = 0; i < 4; ++i) { pg8::Unit uu; if (!S.next(i, uu)) break;
              if (t < 256) { const size_t row = (size_t)uu.pm * 256 + t; const f32x4 p0 = *(const f32x4*)(ssp + row * 8), p1 = *(const f32x4*)(ssp + row * 8 + 4);
                  rl[i * 256 + t] = 1.0f / sqrtf((((p0[0] + p0[1]) + (p0[2] + p0[3])) + ((p1[0] + p1[1]) + (p1[2] + p1[3]))) * (1.0f / DM) + EPS); } }
          __syncthreads(); }
        pg8::EpiSqRelu E{(bf16_t*)(ws + OFF_ACT), DFF, rl};
        pg8::gemm_phase<pg8::EpiSqRelu>(ldsl, g, S, E);
    }
    GSYNC();
    }
    STOP_AT(6);

    {
        pg8::Gemm g{(const bf16_t*)(ws + OFF_ACT), (const bf16_t*)(ws + OFF_W2T), MR, DM, DFF, DFF, DFF};
        pg8::StaticOrder S; S.init(MR, DM, NBLK, bx);
        pg8::EpiFinal E{p.out, DM, (float*)(ws + OFF_SS3P), (unsigned*)(ws + OFF_PCNT), p.final_norm_w, (const bf16_t*)(ws + OFF_H2B)};
        pg8::gemm_phase<pg8::EpiFinal>(ldsl, g, S, E);
    }
}

extern "C" void kernel_launch(void* const* d_in, const int* in_sizes, int n_in, void* d_out, int out_size, void* d_ws, size_t ws_size, hipStream_t stream) {
    static int ready = 0;
    if (!ready) {
        if (n_in != 14 || out_size != MR * DM || ws_size < WS_NEED) { fprintf(stderr, "kernel_launch: unexpected shapes (n_in %d, out %d, ws %zu)\n", n_in, out_size, ws_size); ready = -1; return; }
        if (hipFuncSetAttribute((const void*)hybrid_fwd, hipFuncAttributeMaxDynamicSharedMemorySize, LDS_BYTES) != hipSuccess) { fprintf(stderr, "kernel_launch: hipFuncSetAttribute failed\n"); ready = -1; return; }
        ready = 1;
    }
    if (ready < 0) return;
    Params p{};
    p.x = (const float*)d_in[0]; p.meta = (const float*)d_in[1]; p.norm1_w = (const float*)d_in[2]; p.w_in = (const float*)d_in[3];
    p.gate_w2 = (const float*)d_in[4]; p.gate_b = (const float*)d_in[5]; p.gla_norm_w = (const float*)d_in[6]; p.pool_w = (const float*)d_in[7];
    p.pool_scale = (const float*)d_in[8]; p.w_out = (const float*)d_in[9]; p.norm2_w = (const float*)d_in[10]; p.mlp_w1 = (const float*)d_in[11];
    p.mlp_w2 = (const float*)d_in[12]; p.final_norm_w = (const float*)d_in[13];
    p.out = (float*)d_out; p.ws = (unsigned char*)d_ws;
    p.stop = 99; p.pad = 0;
    if (hipMemsetAsync((unsigned char*)d_ws + OFF_BAR, 0, 16384 + 32 * 256, stream) != hipSuccess) { fprintf(stderr, "kernel_launch: memset failed\n"); return; }
#if PROBE_STOP
    { Params q = p; q.stop = PROBE_STOP; q.pad = PROBE_VAR; void* qa[] = {&q}; (void)hipLaunchCooperativeKernel((void*)hybrid_fwd, dim3(NBLK), dim3(NTHR), qa, LDS_BYTES, stream);
      (void)hipMemsetAsync((unsigned char*)d_ws + OFF_BAR, 0, 16384 + 32 * 256, stream); }
#endif
    void* args[] = {&p};
    hipError_t e = hipLaunchCooperativeKernel((void*)hybrid_fwd, dim3(NBLK), dim3(NTHR), args, LDS_BYTES, stream);
    if (e != hipSuccess) fprintf(stderr, "kernel_launch: cooperative launch failed: %s\n", hipGetErrorString(e));
}
```

```cpp
#include <hip/hip_runtime.h>
#include <hip/hip_cooperative_groups.h>
#include <cstdio>
namespace cg = cooperative_groups;
#ifndef REP_SYNC
#define REP_SYNC 1
#endif
#ifndef REP_P0
#define REP_P0 1
#endif
#ifndef REP_P1
#define REP_P1 1
#endif
#ifndef REP_P2BC
#define REP_P2BC 1
#endif
#ifndef REP_P3
#define REP_P3 1
#endif
#ifndef REP_P4
#define REP_P4 1
#endif
#ifndef PROBE_STOP
#define PROBE_STOP 0
#endif
#ifndef PROBE_VAR
#define PROBE_VAR 0
#endif
#define GSYNC() do { for (int _r = 0; _r < REP_SYNC; ++_r) xcd_barrier(xb); } while (0)
#define STOP_AT(k) do { if (PROBE_STOP && p.stop == (k)) return; } while (0)

#define LAS __attribute__((address_space(3)))
typedef unsigned short bf16_t;
typedef short bf16x8 __attribute__((ext_vector_type(8)));
typedef float f32x4 __attribute__((ext_vector_type(4)));
typedef unsigned u32x4 __attribute__((ext_vector_type(4)));
typedef unsigned u32x2 __attribute__((ext_vector_type(2)));

constexpr int DM = 2048, MR = 8192  , NMETA = 16, MA = MR + NMETA, DIN = 4112, NPROJ = 4096, PLD = 4160  , XLD = 2112  , DFF = 8192;
constexpr float EPS = 1e-6f;
constexpr int NBLK = 256, NTHR = 512;
constexpr int LDS_BYTES = 139264;

constexpr size_t SLOT = 33554432ull;
constexpr size_t OFF_WINT = 0;
constexpr size_t OFF_XB = 17369088;
constexpr size_t OFF_MIXED = 0;
constexpr size_t OFF_PROJ = 52039680;
constexpr size_t OFF_GLR = 120330240;
constexpr size_t OFF_DECAY = 120855552;
constexpr size_t OFF_DSMETA = 121119744;
constexpr size_t OFF_WOUTT = 123216896;
constexpr size_t OFF_POOLWT = 131605504;
constexpr size_t OFF_ACT = 0;
constexpr size_t OFF_W1T = 4 * SLOT;
constexpr size_t OFF_W2T = 5 * SLOT;
constexpr size_t OFF_OINTRA = 6 * SLOT;
constexpr size_t OFF_H2B = 6 * SLOT;
constexpr size_t OFF_SMETAB = 132129792;
constexpr size_t OFF_SPREV = 7 * SLOT;
constexpr size_t OFF_SS2P = 7 * SLOT + 32505856;
constexpr size_t OFF_SS3P = OFF_SS2P + 262144;
constexpr size_t OFF_BAR = OFF_SS3P + 262144;
constexpr size_t OFF_PCNT = OFF_BAR + 16384;
constexpr size_t WS_NEED = 8 * SLOT;

struct Params {
    const float *x, *meta, *norm1_w, *w_in, *gate_w2, *gate_b, *gla_norm_w, *pool_w, *pool_scale, *w_out, *norm2_w, *mlp_w1, *mlp_w2, *final_norm_w;
    float* out; unsigned char* ws; int stop; int pad;
};

typedef __bf16 hwbf16x2 __attribute__((ext_vector_type(2)));
typedef float f32x2v __attribute__((ext_vector_type(2)));
__device__ __forceinline__ unsigned cvt_pk_bf16(float lo, float hi) { const f32x2v f = {lo, hi}; const hwbf16x2 v = __builtin_convertvector(f, hwbf16x2); return __builtin_bit_cast(unsigned, v); }
__device__ __forceinline__ float bf2f(bf16_t u) { return __uint_as_float(((unsigned)u) << 16); }
__device__ __forceinline__ bf16_t f2bf(float f) { unsigned u = __float_as_uint(f); u += 0x7FFFu + ((u >> 16) & 1u); return (bf16_t)(u >> 16); }
__device__ __forceinline__ float wave_sum(float v) {
#pragma unroll
    for (int o = 1; o < 64; o <<= 1) v += __shfl_xor(v, o);
    return v;
}
__device__ __forceinline__ void lds_barrier() { asm volatile("s_waitcnt lgkmcnt(0)" ::: "memory"); __builtin_amdgcn_s_barrier(); asm volatile("" ::: "memory"); }
__device__ __forceinline__ int opaque_tid() { int t = threadIdx.x; asm volatile("" : "+v"(t)); return t; }
__device__ __forceinline__ f32x4 mfma16(bf16x8 a, bf16x8 b, f32x4 c) { return __builtin_amdgcn_mfma_f32_16x16x32_bf16(a, b, c, 0, 0, 0); }


#define XB_TMO      128
#define XB_XCNT(j)  (256  + 64 * (j))
#define XB_XSUB(j)  (1280 + 64 * (j))
#define XB_XGEN(j)  (2304 + 64 * (j))
#define XB_TOP      3328
#define XB_TOPGEN   3392
#define XCD_BAR_WORDS 3456
#define XB_SPIN_CAP (1u << 22)
__device__ __forceinline__ unsigned xb_ld(unsigned* p)              { return __hip_atomic_load(p, __ATOMIC_RELAXED, __HIP_MEMORY_SCOPE_AGENT); }
__device__ __forceinline__ unsigned xb_add(unsigned* p, unsigned v) { return __hip_atomic_fetch_add(p, v, __ATOMIC_RELAXED, __HIP_MEMORY_SCOPE_AGENT); }
__device__ __forceinline__ unsigned xb_xcc_id() { return (unsigned)__builtin_amdgcn_s_getreg((3 << 11) | 20) & 0xFu; }
#define XB_SPIN(cond, bar) do { unsigned _sp = 0; while (cond) { __builtin_amdgcn_s_sleep(1); \
    if ((++_sp & 255u) == 0u) { if (xb_ld(&(bar)[XB_TMO])) break; if (_sp > XB_SPIN_CAP) { atomicAdd(&(bar)[XB_TMO], 1u); break; } } } } while (0)
struct XcdBarrier { unsigned* bar; unsigned x; volatile LAS unsigned* st; };
__device__ __forceinline__ XcdBarrier xcd_barrier_post(unsigned* bar, volatile LAS unsigned* st) {
    XcdBarrier b; b.bar = bar; b.x = xb_xcc_id(); b.st = st;
    if (threadIdx.x == 0) (void)xb_add(&bar[XB_XCNT(b.x)], 1u);
    return b;
}
__device__ __forceinline__ void xcd_barrier_complete(unsigned* bar, unsigned x, unsigned& nloc, unsigned& nx) {
    const unsigned G = gridDim.x * gridDim.y * gridDim.z;
    unsigned sum, cnt, mine, sp = 0u;
    for (;;) {
        sum = 0u; cnt = 0u; mine = 0u;
#pragma unroll
        for (unsigned j = 0; j < 16; ++j) { const unsigned c = xb_ld(&bar[XB_XCNT(j)]); sum += c; cnt += (c > 0u) ? 1u : 0u; mine = (j == x) ? c : mine; }
        if (sum == G) break;
        __builtin_amdgcn_s_sleep(1);
        if ((++sp & 255u) == 0u) { if (xb_ld(&bar[XB_TMO])) break; if (sp > XB_SPIN_CAP) { atomicAdd(&bar[XB_TMO], 1u); break; } }
    }
    nloc = mine > 0u ? mine : 1u; nx = cnt > 0u ? cnt : 1u;
}
__device__ __forceinline__ void xcd_barrier(const XcdBarrier& b) {
    asm volatile("s_waitcnt vmcnt(0)" ::: "memory");
    __syncthreads();
    if (threadIdx.x == 0) {
        unsigned* bar = b.bar;
        __builtin_amdgcn_s_waitcnt(0);
        unsigned nloc = b.st[0], nx = b.st[1];
        if (nloc == 0u) { xcd_barrier_complete(bar, b.x, nloc, nx); b.st[0] = nloc; b.st[1] = nx; }
        const unsigned old = xb_add(&bar[XB_XSUB(b.x)], 1u);
        const unsigned gen = old / nloc;
        if (old + 1u == (gen + 1u) * nloc) {
            __builtin_amdgcn_fence(__ATOMIC_RELEASE, "agent");
            asm volatile("s_waitcnt vmcnt(0)" ::: "memory");
            const unsigned og = xb_add(&bar[XB_TOP], 1u);
            const unsigned tg = og / nx;
            if (og + 1u == (tg + 1u) * nx) xb_add(&bar[XB_TOPGEN], 1u);
            else XB_SPIN(xb_ld(&bar[XB_TOPGEN]) == tg, bar);
            __builtin_amdgcn_fence(__ATOMIC_ACQUIRE, "agent");
            xb_add(&bar[XB_XGEN(b.x)], 1u);
            asm volatile("s_waitcnt vmcnt(0)" ::: "memory");
        } else {
            XB_SPIN(xb_ld(&bar[XB_XGEN(b.x)]) == gen, bar);
            __builtin_amdgcn_fence(__ATOMIC_ACQUIRE, "agent");
            asm volatile("s_waitcnt vmcnt(0)" ::: "memory");
        }
    }
    __syncthreads();
}

namespace pg8 {
constexpr int BM = 256, BK = 64, HALF = 128, HTB = HALF * BK * 2, STAGE_BYTES = 8 * HTB, NXCD = 8, WGM = 4;
__device__ __forceinline__ int lds_byte(int r, int c) { const int st = (r >> 4) * 2 + (c >> 5), rr = r & 15, cc = c & 31, ob = rr * 64 + cc * 2; return st * 1024 + (ob ^ (((ob >> 9) & 1) << 5)); }
__device__ __forceinline__ void stage_rc(int b, int& R, int& C) { const int st = b / 1024, sb = b % 1024, swz = sb ^ (((sb >> 9) & 1) << 5); R = (st >> 1) * 16 + swz / 64; C = (st & 1) * 32 + (swz % 64) / 2; }
__device__ __forceinline__ int perm32(int rho) { const int n = rho >> 4, i = rho & 15; return 8 * (i >> 2) + 4 * n + (i & 3); }

struct Unit { int pm, pn; };
struct Gemm { const bf16_t* A; const bf16_t* Bt; int M, N, K, lda, ldb; };

struct StaticOrder {
    int nM, nN, nwg, G, c;
    __device__ void init(int M, int N, int G_, int c_) { nM = M / BM; nN = N / BM; nwg = nM * nN; G = G_; c = c_; }
    __device__ bool next(int i, Unit& u) const {
        const long L = (long)i * G + c; if (L >= nwg) return false;
        int wgid = (int)L; { const int q = nwg / NXCD, r = nwg % NXCD, xcd = wgid % NXCD, off = wgid / NXCD; wgid = (xcd < r ? xcd * (q + 1) : r * (q + 1) + (xcd - r) * q) + off; }
        const int nig = WGM * nN, gid = wgid / nig, fm = gid * WGM, gsz = (nM - fm) < WGM ? (nM - fm) : WGM;
        u.pm = fm + ((wgid % nig) % gsz); u.pn = (wgid % nig) / gsz; return true;
    }
};


template <class Epi>
__device__ __forceinline__ void gemm_phase(LAS unsigned char* lds, const Gemm g, const StaticOrder& S, const Epi& E) {
    const int tid = opaque_tid(), wid = __builtin_amdgcn_readfirstlane(tid >> 6), lane = tid & 63, wr = wid >> 2, wc = wid & 3, fr = lane & 15, fq = lane >> 4;
    const int K = g.K, nt = K / BK;
    unsigned voffA[2], voffB[2];
#pragma unroll
    for (int i = 0; i < 2; ++i) { int R, C; stage_rc(tid * 16 + i * 8192, R, C); const int Rb = Epi::PERM ? ((R & ~31) + perm32(R & 31)) : R;
        voffA[i] = (unsigned)(R * g.lda + C) * 2u; voffB[i] = (unsigned)(Rb * g.ldb + C) * 2u; }
    const size_t kstep = (size_t)(BK * 2);
    const size_t hstepA = (size_t)HALF * g.lda * 2, hstepB = (size_t)HALF * g.ldb * 2;
    const size_t tstepA = 2 * hstepA, tstepB = 2 * hstepB;
    const unsigned ldsw = (unsigned)wid * 1024u;
    const int aoff = lds_byte(wr * 64 + fr, fq * 8), boff = lds_byte(wc * 32 + fr, fq * 8);
#define PG8_SA(b, h) (((b) * 2 + (h)) * HTB)
#define PG8_SB(b, h) ((4 + (b) * 2 + (h)) * HTB)
#define PG8_STAGE(bufoff, gbase, voff) do { _Pragma("unroll") for (int _i = 0; _i < 2; ++_i) \
        __builtin_amdgcn_global_load_lds((const unsigned*)((const char*)(gbase) + (voff)[_i]), (LAS unsigned*)(lds + (bufoff) + ldsw + _i * 8192), 16, 0, 0); } while (0)
#define PG8_LDA(dst, b, h) do { _Pragma("unroll") for (int m = 0; m < 4; ++m) _Pragma("unroll") for (int k = 0; k < 2; ++k) dst[m][k] = *(const LAS bf16x8*)(lds + PG8_SA(b, h) + aoff + m * 2048 + k * 1024); } while (0)
#define PG8_LDB(dst, b, h) do { _Pragma("unroll") for (int n = 0; n < 2; ++n) _Pragma("unroll") for (int k = 0; k < 2; ++k) dst[n][k] = *(const LAS bf16x8*)(lds + PG8_SB(b, h) + boff + n * 2048 + k * 1024); } while (0)
#define PG8_MMA(ai, bj, At, Bt) do { __builtin_amdgcn_s_setprio(1); _Pragma("unroll") for (int m = 0; m < 4; ++m) _Pragma("unroll") for (int n = 0; n < 2; ++n) _Pragma("unroll") for (int k = 0; k < 2; ++k) \
        acc[ai][bj][m][n] = __builtin_amdgcn_mfma_f32_16x16x32_bf16(Bt[n][k], At[m][k], acc[ai][bj][m][n], 0, 0, 0); __builtin_amdgcn_s_setprio(0); } while (0)
#define PG8_WAIT_V(n) asm volatile("s_waitcnt vmcnt(" #n ")" ::: "memory")
#define PG8_WAIT_L(n) asm volatile("s_waitcnt lgkmcnt(" #n ")" ::: "memory")
#define PG8_BAR __builtin_amdgcn_s_barrier()
#define PG8_SCHED __builtin_amdgcn_sched_barrier(0)
    Unit cur, nxt; int ui = 0;
    if (!S.next(0, cur)) return;
    f32x4 acc[2][2][4][2];
    if constexpr (Epi::INIT) E.init(acc, cur, wr, wc, fr, fq);
    else {
#pragma unroll
    for (int a = 0; a < 2; ++a)
#pragma unroll
        for (int b = 0; b < 2; ++b)
#pragma unroll
            for (int m = 0; m < 4; ++m)
#pragma unroll
                for (int n = 0; n < 2; ++n) acc[a][b][m][n] = (f32x4){0.f, 0.f, 0.f, 0.f};
    }
    bf16x8 At[4][2], B0[2][2], B1[2][2];
    const char* cA = (const char*)g.A + (size_t)cur.pm * tstepA; const char* cB = (const char*)g.Bt + (size_t)cur.pn * tstepB;
    PG8_STAGE(PG8_SB(0, 0), cB, voffB); PG8_STAGE(PG8_SA(0, 0), cA, voffA); PG8_STAGE(PG8_SB(0, 1), cB + hstepB, voffB); PG8_STAGE(PG8_SA(0, 1), cA + hstepA, voffA);
    if (wr == 1) PG8_BAR;
    PG8_WAIT_V(4); PG8_BAR;
    PG8_STAGE(PG8_SB(1, 0), cB + kstep, voffB); PG8_STAGE(PG8_SA(1, 0), cA + kstep, voffA); PG8_STAGE(PG8_SB(1, 1), cB + hstepB + kstep, voffB);
    PG8_WAIT_V(6); PG8_BAR;
    if constexpr (Epi::INIT) {
#pragma unroll
        for (int a = 0; a < 2; ++a)
#pragma unroll
            for (int b = 0; b < 2; ++b)
#pragma unroll
                for (int m = 0; m < 4; ++m) asm volatile("" : "+v"(acc[a][b][m][0]), "+v"(acc[a][b][m][1]));
    }
    for (;;) {
        const bool has_next = S.next(ui + 1, nxt);
        const char* nA = has_next ? (const char*)g.A + (size_t)nxt.pm * tstepA : cA; const char* nB = has_next ? (const char*)g.Bt + (size_t)nxt.pn * tstepB : cB;
        for (int t = 0; t < nt; t += 2) {
            const bool last = (t == nt - 2);
            const char* a1 = cA + (size_t)(t + 1) * kstep;
            const char* a2 = last ? nA : cA + (size_t)(t + 2) * kstep; const char* b2 = last ? nB : cB + (size_t)(t + 2) * kstep;
            const char* a3 = a2 + kstep; const char* b3 = b2 + kstep;
            PG8_LDB(B0, 0, 0); PG8_SCHED; PG8_LDA(At, 0, 0); PG8_STAGE(PG8_SA(1, 1), a1 + hstepA, voffA);
            PG8_WAIT_L(8); PG8_BAR; PG8_WAIT_L(0); PG8_MMA(0, 0, At, B0); PG8_BAR; PG8_SCHED;
            PG8_LDB(B1, 0, 1); PG8_STAGE(PG8_SB(0, 0), b2, voffB);
            PG8_BAR; PG8_WAIT_L(0); PG8_MMA(0, 1, At, B1); PG8_BAR;
            PG8_LDA(At, 0, 1); PG8_STAGE(PG8_SA(0, 0), a2, voffA);
            PG8_BAR; PG8_WAIT_L(0); PG8_MMA(1, 0, At, B0); PG8_BAR; PG8_SCHED;
            PG8_STAGE(PG8_SB(0, 1), b2 + hstepB, voffB);
            PG8_WAIT_V(6); PG8_BAR; PG8_MMA(1, 1, At, B1); PG8_BAR;
            PG8_LDB(B0, 1, 0); PG8_SCHED; PG8_LDA(At, 1, 0); PG8_STAGE(PG8_SA(0, 1), a2 + hstepA, voffA);
            PG8_WAIT_L(8); PG8_BAR; PG8_WAIT_L(0); PG8_MMA(0, 0, At, B0); PG8_BAR; PG8_SCHED;
            PG8_LDB(B1, 1, 1); PG8_STAGE(PG8_SB(1, 0), b3, voffB);
            PG8_BAR; PG8_WAIT_L(0); PG8_MMA(0, 1, At, B1); PG8_BAR;
            PG8_LDA(At, 1, 1); PG8_STAGE(PG8_SA(1, 0), a3, voffA);
            PG8_BAR; PG8_WAIT_L(0); PG8_MMA(1, 0, At, B0); PG8_BAR; PG8_SCHED;
            PG8_STAGE(PG8_SB(1, 1), b3 + hstepB, voffB);
            PG8_WAIT_V(6); PG8_BAR; PG8_MMA(1, 1, At, B1); PG8_BAR;
        }
        if constexpr (!Epi::AFTER_DRAIN) { E(acc, cur, ui, wr, wc, fr, fq); }
        if (!has_next) break;
#pragma unroll
        for (int a = 0; a < 2; ++a)
#pragma unroll
            for (int b = 0; b < 2; ++b)
#pragma unroll
                for (int m = 0; m < 4; ++m)
#pragma unroll
                    for (int n = 0; n < 2; ++n) acc[a][b][m][n] = (f32x4){0.f, 0.f, 0.f, 0.f};
        cur = nxt; cA = nA; cB = nB; ++ui;
    }
    PG8_WAIT_V(0);
    if (wr == 0) PG8_BAR;
    PG8_BAR;
    if constexpr (Epi::AFTER_DRAIN) { E.fused(acc, cur, wr, wc, fr, fq, lds, wid, lane); }
#undef PG8_SA
#undef PG8_SB
#undef PG8_STAGE
#undef PG8_LDA
#undef PG8_LDB
#undef PG8_MMA
#undef PG8_WAIT_V
#undef PG8_WAIT_L
#undef PG8_BAR
#undef PG8_SCHED
}

struct EpiBf16Scale {
    static constexpr bool PERM = true, AFTER_DRAIN = false, INIT = false;
    bf16_t* O; int ldc; const float* colscale;
    __device__ __forceinline__ void operator()(const f32x4 (&acc)[2][2][4][2], const Unit& u, int ui, int wr, int wc, int fr, int fq) const {
        const int row0 = u.pm * BM + wr * 64 + fr, col0 = u.pn * BM + wc * 32 + 8 * fq;
        f32x4 sv[2][2];
#pragma unroll
        for (int bj = 0; bj < 2; ++bj)
#pragma unroll
            for (int n = 0; n < 2; ++n) sv[bj][n] = colscale ? *(const f32x4*)(colscale + col0 + bj * HALF + 4 * n) : (f32x4){1.f, 1.f, 1.f, 1.f};
#pragma unroll
        for (int ai = 0; ai < 2; ++ai)
#pragma unroll
            for (int m = 0; m < 4; ++m) { bf16_t* rowp = O + (size_t)(row0 + ai * HALF + m * 16) * ldc + col0;
#pragma unroll
                for (int bj = 0; bj < 2; ++bj) { const f32x4 v0 = acc[ai][bj][m][0] * sv[bj][0], v1 = acc[ai][bj][m][1] * sv[bj][1];
                    u32x4 w; w.x = cvt_pk_bf16(v0[0], v0[1]); w.y = cvt_pk_bf16(v0[2], v0[3]); w.z = cvt_pk_bf16(v1[0], v1[1]); w.w = cvt_pk_bf16(v1[2], v1[3]);
                    *(u32x4*)(rowp + bj * HALF) = w; } }
    }
};
struct EpiSqRelu {
    static constexpr bool PERM = true, AFTER_DRAIN = false, INIT = false;
    bf16_t* O; int ldc; const LAS float* rl;
    __device__ __forceinline__ void operator()(const f32x4 (&acc)[2][2][4][2], const Unit& u, int ui, int wr, int wc, int fr, int fq) const {
        const int row0 = u.pm * BM + wr * 64 + fr, col0 = u.pn * BM + wc * 32 + 8 * fq;
#pragma unroll
        for (int ai = 0; ai < 2; ++ai)
#pragma unroll
            for (int m = 0; m < 4; ++m) { const int rloc = wr * 64 + fr + ai * HALF + m * 16; const int row = u.pm * BM + rloc;
                const float rstd = rl[ui * 256 + rloc];
                bf16_t* rowp = O + (size_t)row * ldc + col0;
#pragma unroll
                for (int bj = 0; bj < 2; ++bj) { f32x4 v0 = acc[ai][bj][m][0] * rstd, v1 = acc[ai][bj][m][1] * rstd;
#pragma unroll
                    for (int j = 0; j < 4; ++j) { const float a = fmaxf(v0[j], 0.f), b = fmaxf(v1[j], 0.f); v0[j] = a * a; v1[j] = b * b; }
                    u32x4 w; w.x = cvt_pk_bf16(v0[0], v0[1]); w.y = cvt_pk_bf16(v0[2], v0[3]); w.z = cvt_pk_bf16(v1[0], v1[1]); w.w = cvt_pk_bf16(v1[2], v1[3]);
                    *(u32x4*)(rowp + bj * HALF) = w; } }
    }
};
struct EpiResid {
    static constexpr bool PERM = false, AFTER_DRAIN = true, INIT = true;
    const float* base; float* out; bf16_t* outb; int ldc; float* ssp;
    __device__ __forceinline__ void init(f32x4 (&acc)[2][2][4][2], const Unit& u, int wr, int wc, int fr, int fq) const {
        const int col0 = u.pn * BM + wc * 32 + 4 * fq;
#pragma unroll
        for (int ai = 0; ai < 2; ++ai)
#pragma unroll
            for (int m = 0; m < 4; ++m) { const size_t off = (size_t)(u.pm * BM + ai * HALF + wr * 64 + m * 16 + fr) * ldc + col0;
#pragma unroll
                for (int bj = 0; bj < 2; ++bj)
#pragma unroll
                    for (int n = 0; n < 2; ++n) acc[ai][bj][m][n] = __builtin_nontemporal_load((const f32x4*)(base + off + bj * HALF + n * 16)); }
    }
    __device__ __forceinline__ void fused(f32x4 (&acc)[2][2][4][2], const Unit& u, int wr, int wc, int fr, int fq, LAS unsigned char* lds, int wid, int lane) const {
        LAS float* P = (LAS float*)lds;
        const int col0 = u.pn * BM + wc * 32 + 4 * fq;
#pragma unroll
        for (int ai = 0; ai < 2; ++ai)
#pragma unroll
            for (int m = 0; m < 4; ++m) { const int r = ai * HALF + wr * 64 + m * 16 + fr; const size_t off = (size_t)(u.pm * BM + r) * ldc + col0; float s = 0.f;
#pragma unroll
                for (int bj = 0; bj < 2; ++bj)
#pragma unroll
                    for (int n = 0; n < 2; ++n) { const f32x4 o = acc[ai][bj][m][n];
                        if (out) *(f32x4*)(out + off + bj * HALF + n * 16) = o;
                        if (outb) { u32x2 w; w.x = cvt_pk_bf16(o[0], o[1]); w.y = cvt_pk_bf16(o[2], o[3]); *(u32x2*)(outb + off + bj * HALF + n * 16) = w; }
                        s += (o[0] * o[0] + o[1] * o[1]) + (o[2] * o[2] + o[3] * o[3]); }
                s += __shfl_xor(s, 16); s += __shfl_xor(s, 32);
                if (fq == 0) P[r * 4 + wc] = s;
                asm volatile("" ::: "memory"); }
        __syncthreads();
        const int tid = wid * 64 + lane;
        if (tid < 256) { const float s = (P[tid * 4 + 0] + P[tid * 4 + 1]) + (P[tid * 4 + 2] + P[tid * 4 + 3]); ssp[(size_t)(u.pm * BM + tid) * 8 + u.pn] = s; }
        __syncthreads();
    }
};

struct EpiFinal {
    static constexpr bool PERM = false, AFTER_DRAIN = true, INIT = true;
    float* out; int ldc; float* ssp; unsigned* cnt; const float* fnw; const bf16_t* hb;
    __device__ __forceinline__ void init(f32x4 (&acc)[2][2][4][2], const Unit& u, int wr, int wc, int fr, int fq) const {
        const int col0 = u.pn * BM + wc * 32 + 4 * fq;
#pragma unroll
        for (int ai = 0; ai < 2; ++ai)
#pragma unroll
            for (int m = 0; m < 4; ++m) { const size_t off = (size_t)(u.pm * BM + ai * HALF + wr * 64 + m * 16 + fr) * ldc + col0;
#pragma unroll
                for (int bj = 0; bj < 2; ++bj)
#pragma unroll
                    for (int n = 0; n < 2; ++n) { const u32x2 w = __builtin_nontemporal_load((const u32x2*)(hb + off + bj * HALF + n * 16)); acc[ai][bj][m][n] = (f32x4){__uint_as_float(w.x << 16), __uint_as_float(w.x & 0xffff0000u), __uint_as_float(w.y << 16), __uint_as_float(w.y & 0xffff0000u)}; } }
    }
    __device__ __forceinline__ void fused(f32x4 (&acc)[2][2][4][2], const Unit& u, int wr, int wc, int fr, int fq, LAS unsigned char* lds, int wid, int lane) const {
        LAS float* P = (LAS float*)lds;
        LAS float* R = (LAS float*)(lds + 4096);
        const int col0 = u.pn * BM + wc * 32 + 4 * fq;
#pragma unroll
        for (int ai = 0; ai < 2; ++ai)
#pragma unroll
            for (int m = 0; m < 4; ++m) { const int r = ai * HALF + wr * 64 + m * 16 + fr; const size_t off = (size_t)(u.pm * BM + r) * ldc + col0; float s = 0.f;
#pragma unroll
                for (int bj = 0; bj < 2; ++bj)
#pragma unroll
                    for (int n = 0; n < 2; ++n) { const f32x4 o = acc[ai][bj][m][n];
                        s += (o[0] * o[0] + o[1] * o[1]) + (o[2] * o[2] + o[3] * o[3]); }
                s += __shfl_xor(s, 16); s += __shfl_xor(s, 32);
                if (fq == 0) P[r * 4 + wc] = s;
                asm volatile("" ::: "memory"); }
        __syncthreads();
        const int tid = wid * 64 + lane;
        float* slot = ssp + (size_t)(u.pm * BM + (tid & 255)) * 8;
        if (tid < 256) { const float s = (P[tid * 4 + 0] + P[tid * 4 + 1]) + (P[tid * 4 + 2] + P[tid * 4 + 3]); __hip_atomic_store(slot + u.pn, s, __ATOMIC_RELAXED, __HIP_MEMORY_SCOPE_AGENT); }
        asm volatile("s_waitcnt vmcnt(0)" ::: "memory");
        __syncthreads();
        if (tid == 0) {
            unsigned* c = cnt + 64 * u.pm;
            __hip_atomic_fetch_add(c, 1u, __ATOMIC_RELAXED, __HIP_MEMORY_SCOPE_AGENT);
            unsigned sp = 0;
            while (__hip_atomic_load(c, __ATOMIC_RELAXED, __HIP_MEMORY_SCOPE_AGENT) < 8u) { __builtin_amdgcn_s_sleep(1); if (++sp > (1u << 24)) break; }
            __builtin_amdgcn_fence(__ATOMIC_ACQUIRE, "agent");
            asm volatile("s_waitcnt vmcnt(0)" ::: "memory");
        }
        __syncthreads();
        if (tid < 256) { float ss = 0.f;
#pragma unroll
            for (int j = 0; j < 8; ++j) ss += __hip_atomic_load(slot + j, __ATOMIC_RELAXED, __HIP_MEMORY_SCOPE_AGENT);
            R[tid] = 1.0f / sqrtf(ss * (1.0f / DM) + EPS); }
        __syncthreads();
#pragma unroll
        for (int ai = 0; ai < 2; ++ai)
#pragma unroll
            for (int m = 0; m < 4; ++m) { const int r = ai * HALF + wr * 64 + m * 16 + fr; const size_t off = (size_t)(u.pm * BM + r) * ldc + col0; const float rs = R[r];
#pragma unroll
                for (int bj = 0; bj < 2; ++bj)
#pragma unroll
                    for (int n = 0; n < 2; ++n) { const f32x4 fw = *(const f32x4*)(fnw + col0 + bj * HALF + n * 16); *(f32x4*)(out + off + bj * HALF + n * 16) = acc[ai][bj][m][n] * rs * fw; } }
    }
};
}

__device__ __forceinline__ int win_map(int n) { return n < 3072 ? n : (n < 3088 ? n + 1024 : n - 16); }
struct P0Desc { const float* src; const float* scale; bf16_t* dst; int ldn, K, n0, N, k0, map, ldk; };
__device__ __forceinline__ P0Desc p0_decode(const Params& p, unsigned char* ws, int it) {
    constexpr int I_1 = 32 * 128, I_2 = 128 * 32, I_IN = 32 * 65, I_OUT = 32 * 32;
    P0Desc d; int r = it, nblk;
    if (r < I_1) { d.src = p.mlp_w1; d.scale = p.norm2_w; d.dst = (bf16_t*)(ws + OFF_W1T); d.ldn = DFF; d.K = DM; d.N = DFF; d.map = 0; nblk = 128; }
    else if ((r -= I_1) < I_2) { d.src = p.mlp_w2; d.scale = nullptr; d.dst = (bf16_t*)(ws + OFF_W2T); d.ldn = DM; d.K = DFF; d.N = DM; d.map = 0; nblk = 32; }
    else if ((r -= I_2) < I_IN) { d.src = p.w_in; d.scale = p.norm1_w; d.dst = (bf16_t*)(ws + OFF_WINT); d.ldn = DIN; d.K = DM; d.N = DIN; d.map = 1; nblk = 65; }
    else if ((r -= I_IN) < I_OUT) { d.src = p.w_out; d.scale = nullptr; d.dst = (bf16_t*)(ws + OFF_WOUTT); d.ldn = DM; d.K = DM; d.N = DM; d.map = 0; nblk = 32; }
    else { r -= I_OUT; const int g = r >> 4; r &= 15; d.src = p.pool_w + (size_t)g * 65536; d.scale = nullptr; d.dst = (bf16_t*)(ws + OFF_POOLWT) + (size_t)g * 65536; d.ldn = 256; d.K = 256; d.N = 256; d.map = 0; nblk = 4; }
    d.ldk = d.map ? XLD : d.K;
    const int nkb = d.K >> 6; const int nb = r / nkb, kb = r - nb * nkb; d.k0 = kb * 64; d.n0 = nb * 64;
    return d;
}
#define P0_LOAD(d, v) do { const int _n = (d).n0 + lane; const float* _s = (d).src + (size_t)(d).k0 * (d).ldn + (_n < (d).N ? _n : 0); \
    _Pragma("unroll") for (int _i = 0; _i < 64; ++_i) v[_i] = __builtin_nontemporal_load(_s + (size_t)_i * (d).ldn); } while (0)
__device__ __forceinline__ void p0_rows2(const float* r0, const float* r1, bf16_t* o0, bf16_t* o1, bool two, int lane) {
    const f32x4* x0 = (const f32x4*)r0 + lane; const f32x4* x1 = (const f32x4*)r1 + lane; f32x4 v[8], w[8]; float s0 = 0.f, s1 = 0.f;
#pragma unroll
    for (int j = 0; j < 8; ++j) v[j] = __builtin_nontemporal_load(x0 + 64 * j);
    if (two) {
#pragma unroll
        for (int j = 0; j < 8; ++j) w[j] = __builtin_nontemporal_load(x1 + 64 * j);
    } else {
#pragma unroll
        for (int j = 0; j < 8; ++j) w[j] = (f32x4){0.f, 0.f, 0.f, 0.f};
    }
#pragma unroll
    for (int j = 0; j < 8; ++j) { s0 += (v[j][0] * v[j][0] + v[j][1] * v[j][1]) + (v[j][2] * v[j][2] + v[j][3] * v[j][3]); s1 += (w[j][0] * w[j][0] + w[j][1] * w[j][1]) + (w[j][2] * w[j][2] + w[j][3] * w[j][3]); }
    const float rs0 = 1.0f / sqrtf(wave_sum(s0) * (1.0f / DM) + EPS), rs1 = 1.0f / sqrtf(wave_sum(s1) * (1.0f / DM) + EPS);
    u32x2* q0 = (u32x2*)o0 + lane; u32x2* q1 = (u32x2*)o1 + lane;
#pragma unroll
    for (int j = 0; j < 8; ++j) { u32x2 t; t.x = cvt_pk_bf16(v[j][0] * rs0, v[j][1] * rs0); t.y = cvt_pk_bf16(v[j][2] * rs0, v[j][3] * rs0); q0[64 * j] = t; }
    if (two) {
#pragma unroll
        for (int j = 0; j < 8; ++j) { u32x2 t; t.x = cvt_pk_bf16(w[j][0] * rs1, w[j][1] * rs1); t.y = cvt_pk_bf16(w[j][2] * rs1, w[j][3] * rs1); q1[64 * j] = t; }
    }
}
__device__ __forceinline__ void phase0(const Params& p, unsigned char* lds) {
    const int tid = opaque_tid(), lane = tid & 63, wave = tid >> 6;
    LAS float* scr = (LAS float*)((LAS unsigned char*)lds + wave * 16640);
    const int gw = blockIdx.x * 8 + wave, NGW = NBLK * 8;
    unsigned char* ws = p.ws;
    constexpr int NITEMS = 32 * 128 + 128 * 32 + 32 * 65 + 32 * 32 + 4 * 16;
    float v[64];
    int it = (int)(((long)gw * NITEMS) / NGW); const int it_end = (int)(((long)(gw + 1) * NITEMS) / NGW);
    P0Desc d = p0_decode(p, ws, it < it_end ? it : 0);
    if (it < it_end) P0_LOAD(d, v);
    while (it < it_end) {
        const bool ok = d.n0 + lane < d.N;
#pragma unroll
        for (int i = 0; i < 64; ++i) { const float sc = d.scale ? d.scale[d.k0 + i] : 1.0f; scr[i * 65 + lane] = ok ? v[i] * sc : 0.f; }
        asm volatile("s_waitcnt lgkmcnt(0)" ::: "memory"); __builtin_amdgcn_wave_barrier();
        const P0Desc c = d;
        it += 1;
        if (it < it_end) { d = p0_decode(p, ws, it); P0_LOAD(d, v); }
#pragma unroll
        for (int j = 0; j < 8; ++j) { const int pc = lane + 64 * j, nn = pc >> 3, cc = pc & 7; const LAS float* s = scr + (8 * cc) * 65 + nn;
            u32x4 o; o.x = cvt_pk_bf16(s[0], s[65]); o.y = cvt_pk_bf16(s[2 * 65], s[3 * 65]); o.z = cvt_pk_bf16(s[4 * 65], s[5 * 65]); o.w = cvt_pk_bf16(s[6 * 65], s[7 * 65]);
            const int ng = c.n0 + nn;
            if (ng < c.N) { const int row = c.map ? win_map(ng) : ng; *(u32x4*)(c.dst + (size_t)row * c.ldk + c.k0 + 8 * cc) = o; } }
        asm volatile("s_waitcnt lgkmcnt(0)" ::: "memory"); __builtin_amdgcn_wave_barrier();
    }
    {
        bf16_t* xb = (bf16_t*)(ws + OFF_XB);
        const int r0 = 1024 * (blockIdx.x & 7) + ((blockIdx.x >> 3) * 8 + wave);
#pragma unroll 1
        for (int i = 0; i < 4; i += 2) { const int m = r0 + 256 * i, m2 = m + 256;
            p0_rows2(p.x + (size_t)m * DM, p.x + (size_t)m2 * DM, xb + (size_t)m * XLD, xb + (size_t)m2 * XLD, true, lane); }
        if (gw < NMETA) { const float* sm = p.meta + (size_t)gw * DM; bf16_t* om = xb + (size_t)(MR + gw) * XLD; p0_rows2(sm, sm, om, om, false, lane); }
    }
}

__device__ __forceinline__ void phase1_skinny(const Params& p, unsigned char* lds) {
    const int tid = opaque_tid(), lane = tid & 63, wave = tid >> 6;
    unsigned char* ws = p.ws;
    const bf16_t* xb = (const bf16_t*)(ws + OFF_XB); const bf16_t* wint = (const bf16_t*)(ws + OFF_WINT);
    f32x4* red = (f32x4*)lds;
#pragma unroll 1
    for (int task = blockIdx.x; task < 513 + 256; task += NBLK) {
        const bf16_t* Mrows = task < 513 ? xb + (size_t)task * 16 * XLD : xb + (size_t)MR * XLD;
        const bf16_t* Nrows = task < 513 ? wint + (size_t)4096 * XLD : wint + (size_t)(task - 513) * 16 * XLD;
        const bf16x8* mp = (const bf16x8*)(Mrows + (size_t)(lane & 15) * XLD + wave * 256 + 8 * (lane >> 4));
        const bf16x8* np = (const bf16x8*)(Nrows + (size_t)(lane & 15) * XLD + wave * 256 + 8 * (lane >> 4));
        bf16x8 mf[8], nf[8];
#pragma unroll
        for (int kk = 0; kk < 8; ++kk) { mf[kk] = mp[kk * 4]; nf[kk] = np[kk * 4]; }
        f32x4 a = {0.f, 0.f, 0.f, 0.f};
#pragma unroll
        for (int kk = 0; kk < 8; ++kk) a = mfma16(nf[kk], mf[kk], a);
        red[wave * 64 + lane] = a;
        lds_barrier();
        if (wave == 0) {
            f32x4 sacc = red[lane];
#pragma unroll
            for (int w = 1; w < 8; ++w) sacc += red[w * 64 + lane];
            if (task < 513) *(f32x4*)((float*)(ws + OFF_GLR) + (size_t)(task * 16 + (lane & 15)) * 16 + 4 * (lane >> 4)) = sacc;
            else { u32x2 w; w.x = cvt_pk_bf16(sacc[0], sacc[1]); w.y = cvt_pk_bf16(sacc[2], sacc[3]);
                *(u32x2*)((bf16_t*)(ws + OFF_PROJ) + (size_t)(MR + (lane & 15)) * PLD + (task - 513) * 16 + 4 * (lane >> 4)) = w; }
        }
        lds_barrier();
    }
}

constexpr int L_GLR = 0, L_W2 = 4096, L_GSUM = 12288, L_QD = 14336, L_KI = 31744, L_KET = 49152, L_VT = 67584, L_P = 104448;
struct GlaIn { bf16_t qv[16], kv[16], vv[32]; f32x4 glrv, w2v; float gb; };
__device__ __forceinline__ void gla_a_load(const Params& p, int u, GlaIn& r) {
    const int tid = opaque_tid();
    unsigned char* ws = p.ws;
    const bool meta = u >= 512;
    const int h = meta ? (u - 512) : ((u >> 5) & 3);
    const int row0 = meta ? MR : ((u >> 7) * 2048 + (u & 31) * 64);
    const int nvalid = meta ? NMETA : 64;
    const bf16_t* proj = (const bf16_t*)(ws + OFF_PROJ);
    const float* glr = (const float*)(ws + OFF_GLR);
    const int d = tid & 127, tq = tid >> 7, dvc = tid & 255, th = tid >> 8;
#pragma unroll
    for (int i = 0; i < 16; ++i) { const int t = tq * 16 + i, tc = t < nvalid ? t : nvalid - 1; const bf16_t* pr = proj + (size_t)(row0 + tc) * PLD + h * 128 + d; r.qv[i] = __builtin_nontemporal_load(pr); r.kv[i] = __builtin_nontemporal_load(pr + 512); }
#pragma unroll
    for (int i = 0; i < 32; ++i) { const int t = th * 32 + i, tc = t < nvalid ? t : nvalid - 1; r.vv[i] = __builtin_nontemporal_load(proj + (size_t)(row0 + tc) * PLD + 1024 + h * 256 + dvc); }
    r.gb = p.gate_b[h * 128 + d];
    { const int rr = (tid & 255) >> 2, part = tid & 3, rc = rr < nvalid ? rr : nvalid - 1; r.glrv = *(const f32x4*)(glr + (size_t)(row0 + rc) * 16 + part * 4); }
    { const int idx = tid * 4, j = idx >> 7, dd = idx & 127; r.w2v = *(const f32x4*)(p.gate_w2 + j * 512 + h * 128 + dd); }
}
__device__ __forceinline__ void gla_a_compute(const Params& p, unsigned char* lds, int u, const GlaIn& r) {
    const int tid = opaque_tid(), lane = tid & 63, wave = tid >> 6, fr = lane & 15, fq = lane >> 4;
    unsigned char* ws = p.ws;
    const bool meta = u >= 512;
    const int h = meta ? (u - 512) : ((u >> 5) & 3);
    const int row0 = meta ? MR : ((u >> 7) * 2048 + (u & 31) * 64);
    const int nvalid = meta ? NMETA : 64;
    bf16_t* proj = (bf16_t*)(ws + OFF_PROJ);
    float* glr_s = (float*)(lds + L_GLR); float* w2_s = (float*)(lds + L_W2); float* gsum = (float*)(lds + L_GSUM);
    bf16_t* qd_s = (bf16_t*)(lds + L_QD); bf16_t* ki_s = (bf16_t*)(lds + L_KI); bf16_t* ket_s = (bf16_t*)(lds + L_KET); bf16_t* vt_s = (bf16_t*)(lds + L_VT);
    const int d = tid & 127, tq = tid >> 7, dvc = tid & 255, th = tid >> 8;
    const float gb = r.gb;
    if (tid < 256) { const int rr = tid >> 2, part = tid & 3; *(f32x4*)(glr_s + rr * 16 + part * 4) = rr < nvalid ? r.glrv : (f32x4){0.f, 0.f, 0.f, 0.f}; }
    *(f32x4*)(w2_s + tid * 4) = r.w2v;
    lds_barrier();
    {
        float w2c[16];
#pragma unroll
        for (int j = 0; j < 16; ++j) w2c[j] = w2_s[j * 128 + d];
        float G[16]; float run = 0.f;
#pragma unroll
        for (int i = 0; i < 16; ++i) { const int t = tq * 16 + i; const float* gr = glr_s + t * 16; float g = gb;
#pragma unroll
            for (int j = 0; j < 16; ++j) g += gr[j] * w2c[j];
            float lg = (fminf(g, 0.f) - __logf(1.0f + __expf(-fabsf(g)))) * (1.0f / 16.0f);
            if (t >= nvalid) lg = 0.f;
            run += lg; G[i] = run; }
        gsum[tq * 128 + d] = run;
        lds_barrier();
        float off = 0.f, tot = 0.f;
#pragma unroll
        for (int q = 0; q < 4; ++q) { const float sg = gsum[q * 128 + d]; tot += sg; if (q < tq) off += sg; }
#pragma unroll
        for (int i = 0; i < 16; ++i) { const int t = tq * 16 + i; const float Gt = off + G[i];
            const float q = t < nvalid ? bf2f(r.qv[i]) : 0.f, k = t < nvalid ? bf2f(r.kv[i]) : 0.f;
            const bf16_t qdb = f2bf(q * 0.08838834764831845f * __expf(Gt));
            qd_s[t * 136 + d] = qdb; ki_s[t * 136 + d] = f2bf(k * __expf(-Gt)); ket_s[d * 72 + t] = f2bf(k * __expf(tot - Gt));
            if (!meta) proj[(size_t)(row0 + t) * PLD + h * 128 + d] = qdb; }
        if (tq == 0) ((float*)(ws + OFF_DECAY))[u * 128 + d] = __expf(tot);
    }
#pragma unroll
    for (int i = 0; i < 32; ++i) { const int t = th * 32 + i; vt_s[dvc * 72 + t] = t < nvalid ? r.vv[i] : (bf16_t)0; }
    lds_barrier();
    if (!meta) {
#pragma unroll
        for (int ii = 0; ii < 2; ++ii) { const int idx = 2 * wave + ii, tt = idx >> 2, ss = idx & 3; f32x4 acc = {0.f, 0.f, 0.f, 0.f};
            if (ss <= tt) {
#pragma unroll
                for (int kk = 0; kk < 4; ++kk) { const bf16x8 mf = *(const bf16x8*)(lds + L_QD + (tt * 16 + fr) * 272 + (kk * 32 + 8 * fq) * 2);
                    const bf16x8 nf = *(const bf16x8*)(lds + L_KI + (ss * 16 + fr) * 272 + (kk * 32 + 8 * fq) * 2); acc = mfma16(nf, mf, acc); } }
            const int t = tt * 16 + fr, s0 = ss * 16 + 4 * fq;
#pragma unroll
            for (int j = 0; j < 4; ++j) if (s0 + j > t) acc[j] = 0.f;
            u32x2 w; w.x = cvt_pk_bf16(acc[0], acc[1]); w.y = cvt_pk_bf16(acc[2], acc[3]);
            *(u32x2*)(lds + L_P + t * 144 + s0 * 2) = w; }
    }
    lds_barrier();
    if (!meta) {
        f32x4 o[4][2];
#pragma unroll
        for (int tt = 0; tt < 4; ++tt) { o[tt][0] = (f32x4){0.f, 0.f, 0.f, 0.f}; o[tt][1] = (f32x4){0.f, 0.f, 0.f, 0.f}; }
#pragma unroll
        for (int kk = 0; kk < 2; ++kk) { bf16x8 nf[2];
#pragma unroll
            for (int dd = 0; dd < 2; ++dd) nf[dd] = *(const bf16x8*)(lds + L_VT + (wave * 32 + dd * 16 + fr) * 144 + (kk * 32 + 8 * fq) * 2);
#pragma unroll
            for (int tt = 0; tt < 4; ++tt) { const bf16x8 mf = *(const bf16x8*)(lds + L_P + (tt * 16 + fr) * 144 + (kk * 32 + 8 * fq) * 2);
                o[tt][0] = mfma16(nf[0], mf, o[tt][0]); o[tt][1] = mfma16(nf[1], mf, o[tt][1]); } }
        u32x2* dump = (u32x2*)(ws + OFF_OINTRA) + ((size_t)(u * 8 + wave) * 8) * 64 + lane;
#pragma unroll
        for (int tt = 0; tt < 4; ++tt)
#pragma unroll
            for (int dd = 0; dd < 2; ++dd) { u32x2 w; w.x = cvt_pk_bf16(o[tt][dd][0], o[tt][dd][1]); w.y = cvt_pk_bf16(o[tt][dd][2], o[tt][dd][3]); dump[(tt * 2 + dd) * 64] = w; }
    }
    {
        bf16_t* dsb = meta ? (bf16_t*)(ws + OFF_DSMETA) + (size_t)h * 32768 : (bf16_t*)p.out + (size_t)u * 32768;
#pragma unroll
        for (int dvt = 0; dvt < 2; ++dvt) { f32x4 acc[8];
#pragma unroll
            for (int i = 0; i < 8; ++i) acc[i] = (f32x4){0.f, 0.f, 0.f, 0.f};
#pragma unroll
            for (int kk = 0; kk < 2; ++kk) { const bf16x8 mf = *(const bf16x8*)(lds + L_VT + (wave * 32 + dvt * 16 + fr) * 144 + (kk * 32 + 8 * fq) * 2);
#pragma unroll
                for (int dkt = 0; dkt < 8; ++dkt) { const bf16x8 nf = *(const bf16x8*)(lds + L_KET + (dkt * 16 + fr) * 144 + (kk * 32 + 8 * fq) * 2); acc[dkt] = mfma16(nf, mf, acc[dkt]); } }
            bf16_t* dst = dsb + (size_t)(wave * 32 + dvt * 16 + fr) * 128 + 4 * fq;
#pragma unroll
            for (int dkt = 0; dkt < 8; ++dkt) { u32x2 w; w.x = cvt_pk_bf16(acc[dkt][0], acc[dkt][1]); w.y = cvt_pk_bf16(acc[dkt][2], acc[dkt][3]); *(u32x2*)(dst + dkt * 16) = w; } }
    }
    lds_barrier();
}
template <int W>
__device__ __forceinline__ void pool_y_rows(const bf16_t* __restrict__ proj, bf16_t* __restrict__ mixed, int b, int t0, int ch0) {
    u32x4 rows[8 + W];
#pragma unroll
    for (int i = 0; i < 8 + W; ++i) { const int tt = t0 - W + i; const size_t row = tt >= 0 ? (size_t)b * 2048 + tt : (size_t)(MR + NMETA + tt);
        rows[i] = *(const u32x4*)(proj + row * PLD + 3072 + ch0); }
    float sum[8];
#pragma unroll
    for (int e = 0; e < 8; ++e) sum[e] = 0.f;
#define POOL_UNPK(v, dst) do { dst[0] = __uint_as_float((v).x << 16); dst[1] = __uint_as_float((v).x & 0xffff0000u); dst[2] = __uint_as_float((v).y << 16); dst[3] = __uint_as_float((v).y & 0xffff0000u); \
        dst[4] = __uint_as_float((v).z << 16); dst[5] = __uint_as_float((v).z & 0xffff0000u); dst[6] = __uint_as_float((v).w << 16); dst[7] = __uint_as_float((v).w & 0xffff0000u); } while (0)
#pragma unroll
    for (int i = 1; i < W; ++i) { float v[8]; POOL_UNPK(rows[i], v);
#pragma unroll
        for (int e = 0; e < 8; ++e) sum[e] += v[e]; }
    constexpr float inv = 1.0f / (float)W;
#pragma unroll
    for (int i = 0; i < 8; ++i) { float nv[8]; POOL_UNPK(rows[W + i], nv);
        float y[8];
#pragma unroll
        for (int e = 0; e < 8; ++e) { sum[e] += nv[e]; y[e] = sum[e] * inv - nv[e]; }
        float ov[8]; POOL_UNPK(rows[i + 1], ov);
#pragma unroll
        for (int e = 0; e < 8; ++e) sum[e] -= ov[e];
        u32x4 o; o.x = cvt_pk_bf16(y[0], y[1]); o.y = cvt_pk_bf16(y[2], y[3]); o.z = cvt_pk_bf16(y[4], y[5]); o.w = cvt_pk_bf16(y[6], y[7]);
        *(u32x4*)(mixed + ((size_t)b * 2048 + t0 + i) * DM + ch0) = o; }
#undef POOL_UNPK
}
__device__ __forceinline__ void pool_y_task(const Params& p, int task) {
    const int tid = opaque_tid(), lane = tid & 63, wave = tid >> 6, g = wave >> 1;
    const int ch0 = g * 256 + (lane & 31) * 8;
    const int b = task >> 6, t0 = (task & 63) * 32 + (wave & 1) * 16 + (lane >> 5) * 8;
    const bf16_t* proj = (const bf16_t*)(p.ws + OFF_PROJ); bf16_t* mixed = (bf16_t*)(p.ws + OFF_MIXED);
    if (g == 0) pool_y_rows<2>(proj, mixed, b, t0, ch0);
    else if (g == 1) pool_y_rows<4>(proj, mixed, b, t0, ch0);
    else if (g == 2) pool_y_rows<8>(proj, mixed, b, t0, ch0);
    else pool_y_rows<16>(proj, mixed, b, t0, ch0);
}

__device__ __forceinline__ void gla_scan(const Params& p, const int e) {
    unsigned char* ws = p.ws;
    const int bh = e >> 13, rem = e & 8191, h = bh & 3;
    const size_t eo = (size_t)rem * 4;
    const int dk4 = (rem & 31) * 4;
    const u32x2 sm0 = *(const u32x2*)((const bf16_t*)(ws + OFF_DSMETA) + (size_t)h * 32768 + eo);
    f32x4 S = {__uint_as_float(sm0.x << 16), __uint_as_float(sm0.x & 0xffff0000u), __uint_as_float(sm0.y << 16), __uint_as_float(sm0.y & 0xffff0000u)};
    const bf16_t* ds = (const bf16_t*)p.out + (size_t)bh * 32 * 32768 + eo;
    const float* dec = (const float*)(ws + OFF_DECAY) + (size_t)bh * 32 * 128 + dk4;
    bf16_t* sp = (bf16_t*)(ws + OFF_SPREV) + (size_t)bh * 31 * 32768 + eo;
    bf16_t* sm = (bf16_t*)(ws + OFF_SMETAB) + (size_t)h * 32768 + eo;
    u32x2 d0[8], d1[8]; f32x4 a0[8], a1[8];
#define SCAN_LD(db, ab, c0) do { _Pragma("unroll") for (int _j = 0; _j < 8; ++_j) { db[_j] = __builtin_nontemporal_load((const u32x2*)(ds + (size_t)((c0) + _j) * 32768)); ab[_j] = *(const f32x4*)(dec + ((c0) + _j) * 128); } } while (0)
#define SCAN_DO(db, ab, c0) do { _Pragma("unroll") for (int _j = 0; _j < 8; ++_j) { const int _c = (c0) + _j; u32x2 _w; _w.x = cvt_pk_bf16(S[0], S[1]); _w.y = cvt_pk_bf16(S[2], S[3]); \
        if (_c == 0) { if (bh < 4) *(u32x2*)sm = _w; } else *(u32x2*)(sp + (size_t)(_c - 1) * 32768) = _w; \
        const f32x4 _d = {__uint_as_float(db[_j].x << 16), __uint_as_float(db[_j].x & 0xffff0000u), __uint_as_float(db[_j].y << 16), __uint_as_float(db[_j].y & 0xffff0000u)}; \
        S = ab[_j] * S + _d; } } while (0)
    SCAN_LD(d0, a0, 0); SCAN_LD(d1, a1, 8);
    SCAN_DO(d0, a0, 0); SCAN_LD(d0, a0, 16);
    SCAN_DO(d1, a1, 8); SCAN_LD(d1, a1, 24);
    SCAN_DO(d0, a0, 16);
    SCAN_DO(d1, a1, 24);
#undef SCAN_LD
#undef SCAN_DO
}

__device__ __forceinline__ void gla_c_unit(const Params& p, unsigned char* lds, int u) {
    const int tid = opaque_tid(), lane = tid & 63, wave = tid >> 6, fr = lane & 15, fq = lane >> 4;
    unsigned char* ws = p.ws;
    const int h = (u >> 5) & 3, row0 = (u >> 7) * 2048 + (u & 31) * 64;
    const bf16_t* proj = (const bf16_t*)(ws + OFF_PROJ);
    f32x4 o[4][2];
    const u32x2* dump = (const u32x2*)(ws + OFF_OINTRA) + ((size_t)(u * 8 + wave) * 8) * 64 + lane;
    const bf16_t* qbase = proj + (size_t)(row0 + fr) * PLD + h * 128 + 8 * fq;
    const int cch = u & 31, bhh = u >> 5;
    const bf16_t* sbase = (cch == 0 ? (const bf16_t*)(ws + OFF_SMETAB) + (size_t)h * 32768 : (const bf16_t*)(ws + OFF_SPREV) + (size_t)(bhh * 31 + cch - 1) * 32768) + (size_t)(wave * 32 + fr) * 128 + 8 * fq;
    bf16x8 nf[4][2], mf[4][4]; u32x2 rr[4][2]; f32x4 nw[2];
#pragma unroll
    for (int kk = 0; kk < 4; ++kk) {
#pragma unroll
        for (int dd = 0; dd < 2; ++dd) nf[kk][dd] = __builtin_nontemporal_load((const bf16x8*)(sbase + dd * 16 * 128 + kk * 32));
#pragma unroll
        for (int tt = 0; tt < 4; ++tt) mf[kk][tt] = *(const bf16x8*)(qbase + (size_t)tt * 16 * PLD + kk * 32); }
#pragma unroll
    for (int tt = 0; tt < 4; ++tt)
#pragma unroll
        for (int dd = 0; dd < 2; ++dd) { const u32x2 w = __builtin_nontemporal_load(dump + (tt * 2 + dd) * 64); o[tt][dd] = (f32x4){__uint_as_float(w.x << 16), __uint_as_float(w.x & 0xffff0000u), __uint_as_float(w.y << 16), __uint_as_float(w.y & 0xffff0000u)}; }
#pragma unroll
    for (int tt = 0; tt < 4; ++tt)
#pragma unroll
        for (int dd = 0; dd < 2; ++dd) rr[tt][dd] = __builtin_nontemporal_load((const u32x2*)(proj + (size_t)(row0 + tt * 16 + fr) * PLD + 2048 + h * 256 + wave * 32 + dd * 16 + 4 * fq));
#pragma unroll
    for (int dd = 0; dd < 2; ++dd) nw[dd] = *(const f32x4*)(p.gla_norm_w + wave * 32 + dd * 16 + 4 * fq);
#pragma unroll
    for (int kk = 0; kk < 4; ++kk)
#pragma unroll
        for (int tt = 0; tt < 4; ++tt) { o[tt][0] = mfma16(nf[kk][0], mf[kk][tt], o[tt][0]); o[tt][1] = mfma16(nf[kk][1], mf[kk][tt], o[tt][1]); }
    float* ssq = (float*)lds;
#pragma unroll
    for (int tt = 0; tt < 4; ++tt) { float s = 0.f;
#pragma unroll
        for (int dd = 0; dd < 2; ++dd) s += (o[tt][dd][0] * o[tt][dd][0] + o[tt][dd][1] * o[tt][dd][1]) + (o[tt][dd][2] * o[tt][dd][2] + o[tt][dd][3] * o[tt][dd][3]);
        s += __shfl_xor(s, 16); s += __shfl_xor(s, 32);
        if (fq == 0) ssq[(tt * 16 + fr) * 8 + wave] = s; }
    lds_barrier();
    bf16_t* mixed = (bf16_t*)(ws + OFF_MIXED);
#pragma unroll
    for (int tt = 0; tt < 4; ++tt) { const int t = tt * 16 + fr;
        const f32x4 a = *(const f32x4*)(ssq + t * 8), b = *(const f32x4*)(ssq + t * 8 + 4);
        const float tot = ((a[0] + a[1]) + (a[2] + a[3])) + ((b[0] + b[1]) + (b[2] + b[3]));
        const float rstd = 1.0f / sqrtf(tot * (1.0f / 256.0f) + EPS);
#pragma unroll
        for (int dd = 0; dd < 2; ++dd) { const int dv = wave * 32 + dd * 16 + 4 * fq;
            const u32x2 rv = rr[tt][dd];
            float r[4] = {__uint_as_float(rv.x << 16), __uint_as_float(rv.x & 0xffff0000u), __uint_as_float(rv.y << 16), __uint_as_float(rv.y & 0xffff0000u)};
            float y[4];
#pragma unroll
            for (int j = 0; j < 4; ++j) y[j] = o[tt][dd][j] * rstd * nw[dd][j] * (r[j] / (1.0f + __expf(-r[j])));
            u32x2 w; w.x = cvt_pk_bf16(y[0], y[1]); w.y = cvt_pk_bf16(y[2], y[3]);
            *(u32x2*)(mixed + (size_t)(row0 + t) * DM + h * 256 + dv) = w; } }
    lds_barrier();
}

__device__ __forceinline__ void phase6(const Params& p) {
    const int tid = opaque_tid(), lane = tid & 63, wave = tid >> 6, gw = blockIdx.x * 8 + wave;
    const float* ssp = (const float*)(p.ws + OFF_SS3P);
    f32x4 fw[8];
#pragma unroll
    for (int j = 0; j < 8; ++j) fw[j] = ((const f32x4*)p.final_norm_w)[lane + 64 * j];
    for (int m = gw; m < MR; m += NBLK * 8) {
        const f32x4 p0 = *(const f32x4*)(ssp + (size_t)m * 8), p1 = *(const f32x4*)(ssp + (size_t)m * 8 + 4);
        const float ss = ((p0[0] + p0[1]) + (p0[2] + p0[3])) + ((p1[0] + p1[1]) + (p1[2] + p1[3]));
        const float rstd = 1.0f / sqrtf(ss * (1.0f / DM) + EPS);
        f32x4* row = (f32x4*)(p.out + (size_t)m * DM) + lane;
#pragma unroll
        for (int j = 0; j < 8; ++j) { f32x4 v = row[64 * j]; row[64 * j] = v * rstd * fw[j]; }
    }
}

__global__ void __launch_bounds__(NTHR, 2) hybrid_fwd(Params p) {
    extern __shared__ __attribute__((aligned(16))) unsigned char lds[];
    cg::grid_group grid = cg::this_grid();
    LAS unsigned char* ldsl = (LAS unsigned char*)lds;
    unsigned char* ws = p.ws;
    const int bx = blockIdx.x;
    const int xl = bx & 7, rk = bx >> 3;
    const int uA = (xl >> 1) * 128 + (2 * (rk >> 4)) * 32 + 16 * (xl & 1) + (rk & 15), uB = uA + 32;
    const int ptask = (xl >> 1) * 64 + (xl & 1) * 32 + rk;
    const int ptask_lo = (((bx - 4) & 7) >> 1) * 64 + (((bx - 4) & 7) & 1) * 32 + ((bx - 4) >> 3);

    volatile LAS unsigned* xst = (volatile LAS unsigned*)(ldsl + LDS_BYTES - 16);
    if (threadIdx.x < 4) xst[threadIdx.x] = 0u;
    unsigned* barw = (unsigned*)(ws + OFF_BAR);
    __syncthreads();
    XcdBarrier xb = xcd_barrier_post(barw, xst);
    if (p.stop == 0x7fffffff) grid.sync();

    phase0(p, lds);
    GSYNC();
#pragma unroll 1
    for (int _q = 1; _q < REP_P0; ++_q) { phase0(p, lds); GSYNC(); }

#pragma unroll 1
    for (int _q = 0; _q < REP_P1; ++_q) {
    phase1_skinny(p, lds);
    __syncthreads();
    {
        pg8::Gemm g{(const bf16_t*)(ws + OFF_XB), (const bf16_t*)(ws + OFF_WINT), MR, NPROJ, DM, XLD, XLD};
        pg8::StaticOrder S; S.init(MR, NPROJ, NBLK, bx);
        pg8::EpiBf16Scale E{(bf16_t*)(ws + OFF_PROJ), PLD, nullptr};
        pg8::gemm_phase<pg8::EpiBf16Scale>(ldsl, g, S, E);
    }
    GSYNC();
    }
    STOP_AT(1);

#if PROBE_STOP
    if (p.pad) { const int var = p.pad; GlaIn ra;
        if (!(var & 8)) { if (bx < 4 && !(var & 2)) { gla_a_load(p, 512 + bx, ra); gla_a_compute(p, lds, 512 + bx, ra); }
            gla_a_load(p, bx, ra); gla_a_compute(p, lds, bx, ra);
            if (!(var & 4)) { gla_a_load(p, bx + NBLK, ra); gla_a_compute(p, lds, bx + NBLK, ra); } }
        if (!(var & 1)) { if (bx >= 4) pool_y_task(p, bx); if (bx >= 4 && bx < 8) pool_y_task(p, bx - 4); }
    } else
#endif
    {
    {
        GlaIn ra, rb;
        if (bx < 4) { gla_a_load(p, 512 + bx, ra); gla_a_load(p, uA, rb); gla_a_compute(p, lds, 512 + bx, ra); gla_a_load(p, uB, ra); gla_a_compute(p, lds, uA, rb); gla_a_compute(p, lds, uB, ra); }
        else { gla_a_load(p, uA, ra); gla_a_load(p, uB, rb); gla_a_compute(p, lds, uA, ra); gla_a_compute(p, lds, uB, rb); }
    }
    if (bx >= 4) pool_y_task(p, ptask);
    if (bx >= 4 && bx < 8) pool_y_task(p, ptask_lo);
    }
    GSYNC();
    STOP_AT(2);

#pragma unroll 1
    for (int _q = 0; _q < REP_P2BC; ++_q) {
    if (bx < 128 && _q == 0) {
        const int gq = bx >> 5;
        pg8::Gemm g{(const bf16_t*)(ws + OFF_MIXED) + gq * 256, (const bf16_t*)(ws + OFF_POOLWT) + (size_t)gq * 65536, MR, 256, 256, DM, 256};
        pg8::StaticOrder S; S.init(MR, 256, 32, bx & 31);
        pg8::EpiBf16Scale E{(bf16_t*)(ws + OFF_MIXED) + 1024 + gq * 256, DM, p.pool_scale + gq * 256};
        pg8::gemm_phase<pg8::EpiBf16Scale>(ldsl, g, S, E);
    } else {
        const int li = ((bx >> 3) - 16) * 2 + (bx & 1);
        const int e0 = ((bx & 7) >> 1) * 32768 + li * NTHR + opaque_tid();
        gla_scan(p, e0);
        gla_scan(p, e0 + 16384);
    }
    GSYNC();
    STOP_AT(3);

    gla_c_unit(p, lds, uA); gla_c_unit(p, lds, uB);
    GSYNC();
    }
    STOP_AT(4);

#pragma unroll 1
    for (int _q = 0; _q < REP_P3; ++_q) {
    {
        pg8::Gemm g{(const bf16_t*)(ws + OFF_MIXED), (const bf16_t*)(ws + OFF_WOUTT), MR, DM, DM, DM, DM};
        pg8::StaticOrder S; S.init(MR, DM, NBLK, bx);
        pg8::EpiResid E{p.x, nullptr, (bf16_t*)(ws + OFF_H2B), DM, (float*)(ws + OFF_SS2P)};
        pg8::gemm_phase<pg8::EpiResid>(ldsl, g, S, E);
    }
    GSYNC();
    }
    STOP_AT(5);

#pragma unroll 1
    for (int _q = 0; _q < REP_P4; ++_q) {
    {
        pg8::Gemm g{(const bf16_t*)(ws + OFF_H2B), (const bf16_t*)(ws + OFF_W1T), MR, DFF, DM, DM, DM};
        pg8::StaticOrder S; S.init(MR, DFF, NBLK, bx);
        LAS float* rl = (LAS float*)(ldsl + pg8::STAGE_BYTES);
        { const int t = opaque_tid(); const float* ssp = (const float*)(ws + OFF_SS2P);
#pragma unroll 1
          for (int i = 0; i < 4; ++i) { pg8::Unit uu; if (!S.next(i, uu)) break;
              if (t < 256) { const size_t row = (size_t)uu.pm * 256 + t; const f32x4 p0 = *(const f32x4*)(ssp + row * 8), p1 = *(const f32x4*)(ssp + row * 8 + 4);
                  rl[i * 256 + t] = 1.0f / sqrtf((((p0[0] + p0[1]) + (p0[2] + p0[3])) + ((p1[0] + p1[1]) + (p1[2] + p1[3]))) * (1.0f / DM) + EPS); } }
          __syncthreads(); }
        pg8::EpiSqRelu E{(bf16_t*)(ws + OFF_ACT), DFF, rl};
        pg8::gemm_phase<pg8::EpiSqRelu>(ldsl, g, S, E);
    }
    GSYNC();
    }
    STOP_AT(6);

    {
        pg8::Gemm g{(const bf16_t*)(ws + OFF_ACT), (const bf16_t*)(ws + OFF_W2T), MR, DM, DFF, DFF, DFF};
        pg8::StaticOrder S; S.init(MR, DM, NBLK, bx);
        pg8::EpiFinal E{p.out, DM, (float*)(ws + OFF_SS3P), (unsigned*)(ws + OFF_PCNT), p.final_norm_w, (const bf16_t*)(ws + OFF_H2B)};
        pg8::gemm_phase<pg8::EpiFinal>(ldsl, g, S, E);
    }
}

extern "C" void kernel_launch(void* const* d_in, const int* in_sizes, int n_in, void* d_out, int out_size, void* d_ws, size_t ws_size, hipStream_t stream) {
    static int ready = 0;
    if (!ready) {
        if (n_in != 14 || out_size != MR * DM || ws_size < WS_NEED) { fprintf(stderr, "kernel_launch: unexpected shapes (n_in %d, out %d, ws %zu)\n", n_in, out_size, ws_size); ready = -1; return; }
        if (hipFuncSetAttribute((const void*)hybrid_fwd, hipFuncAttributeMaxDynamicSharedMemorySize, LDS_BYTES) != hipSuccess) { fprintf(stderr, "kernel_launch: hipFuncSetAttribute failed\n"); ready = -1; return; }
        ready = 1;
    }
    if (ready < 0) return;
    Params p{};
    p.x = (const float*)d_in[0]; p.meta = (const float*)d_in[1]; p.norm1_w = (const float*)d_in[2]; p.w_in = (const float*)d_in[3];
    p.gate_w2 = (const float*)d_in[4]; p.gate_b = (const float*)d_in[5]; p.gla_norm_w = (const float*)d_in[6]; p.pool_w = (const float*)d_in[7];
    p.pool_scale = (const float*)d_in[8]; p.w_out = (const float*)d_in[9]; p.norm2_w = (const float*)d_in[10]; p.mlp_w1 = (const float*)d_in[11];
    p.mlp_w2 = (const float*)d_in[12]; p.final_norm_w = (const float*)d_in[13];
    p.out = (float*)d_out; p.ws = (unsigned char*)d_ws;
    p.stop = 99; p.pad = 0;
    if (hipMemsetAsync((unsigned char*)d_ws + OFF_BAR, 0, 16384 + 32 * 256, stream) != hipSuccess) { fprintf(stderr, "kernel_launch: memset failed\n"); return; }
#if PROBE_STOP
    { Params q = p; q.stop = PROBE_STOP; q.pad = PROBE_VAR; void* qa[] = {&q}; (void)hipLaunchCooperativeKernel((void*)hybrid_fwd, dim3(NBLK), dim3(NTHR), qa, LDS_BYTES, stream);
      (void)hipMemsetAsync((unsigned char*)d_ws + OFF_BAR, 0, 16384 + 32 * 256, stream); }
#endif
    void* args[] = {&p};
    hipError_t e = hipLaunchCooperativeKernel((void*)hybrid_fwd, dim3(NBLK), dim3(NTHR), args, LDS_BYTES, stream);
    if (e != hipSuccess) fprintf(stderr, "kernel_launch: cooperative launch failed: %s\n", hipGetErrorString(e));
}
```

```cpp
#include <hip/hip_runtime.h>
#include <hip/hip_cooperative_groups.h>
#include <cstdio>
namespace cg = cooperative_groups;
#ifndef REP_SYNC
#define REP_SYNC 1
#endif
#ifndef REP_P0
#define REP_P0 1
#endif
#ifndef REP_P1
#define REP_P1 1
#endif
#ifndef REP_P2BC
#define REP_P2BC 1
#endif
#ifndef REP_P3
#define REP_P3 1
#endif
#ifndef REP_P4
#define REP_P4 1
#endif
#ifndef PROBE_STOP
#define PROBE_STOP 0
#endif
#ifndef PROBE_VAR
#define PROBE_VAR 0
#endif
#define GSYNC() do { for (int _r = 0; _r < REP_SYNC; ++_r) xcd_barrier(xb); } while (0)
#define STOP_AT(k) do { if (PROBE_STOP && p.stop == (k)) return; } while (0)

#define LAS __attribute__((address_space(3)))
typedef unsigned short bf16_t;
typedef short bf16x8 __attribute__((ext_vector_type(8)));
typedef float f32x4 __attribute__((ext_vector_type(4)));
typedef unsigned u32x4 __attribute__((ext_vector_type(4)));
typedef unsigned u32x2 __attribute__((ext_vector_type(2)));

constexpr int DM = 2048, MR = 8192  , NMETA = 16, MA = MR + NMETA, DIN = 4112, NPROJ = 4096, PLD = 4160  , XLD = 2112  , DFF = 8192;
constexpr float EPS = 1e-6f;
constexpr int NBLK = 256, NTHR = 512;
constexpr int LDS_BYTES = 139264;

constexpr size_t SLOT = 33554432ull;
constexpr size_t OFF_WINT = 0;
constexpr size_t OFF_XB = 17369088;
constexpr size_t OFF_MIXED = 0;
constexpr size_t OFF_PROJ = 52039680;
constexpr size_t OFF_GLR = 120330240;
constexpr size_t OFF_DECAY = 120855552;
constexpr size_t OFF_DSMETA = 121119744;
constexpr size_t OFF_WOUTT = 123216896;
constexpr size_t OFF_POOLWT = 131605504;
constexpr size_t OFF_ACT = 0;
constexpr size_t OFF_W1T = 4 * SLOT;
constexpr size_t OFF_W2T = 5 * SLOT;
constexpr size_t OFF_OINTRA = 6 * SLOT;
constexpr size_t OFF_H2B = 6 * SLOT;
constexpr size_t OFF_SMETAB = 132129792;
constexpr size_t OFF_SPREV = 7 * SLOT;
constexpr size_t OFF_SS2P = 7 * SLOT + 32505856;
constexpr size_t OFF_SS3P = OFF_SS2P + 262144;
constexpr size_t OFF_BAR = OFF_SS3P + 262144;
constexpr size_t OFF_PCNT = OFF_BAR + 16384;
constexpr size_t WS_NEED = 8 * SLOT;

struct Params {
    const float *x, *meta, *norm1_w, *w_in, *gate_w2, *gate_b, *gla_norm_w, *pool_w, *pool_scale, *w_out, *norm2_w, *mlp_w1, *mlp_w2, *final_norm_w;
    float* out; unsigned char* ws; int stop; int pad;
};

typedef __bf16 hwbf16x2 __attribute__((ext_vector_type(2)));
typedef float f32x2v __attribute__((ext_vector_type(2)));
__device__ __forceinline__ unsigned cvt_pk_bf16(float lo, float hi) { const f32x2v f = {lo, hi}; const hwbf16x2 v = __builtin_convertvector(f, hwbf16x2); return __builtin_bit_cast(unsigned, v); }
__device__ __forceinline__ float bf2f(bf16_t u) { return __uint_as_float(((unsigned)u) << 16); }
__device__ __forceinline__ bf16_t f2bf(float f) { unsigned u = __float_as_uint(f); u += 0x7FFFu + ((u >> 16) & 1u); return (bf16_t)(u >> 16); }
__device__ __forceinline__ float wave_sum(float v) {
#pragma unroll
    for (int o = 1; o < 64; o <<= 1) v += __shfl_xor(v, o);
    return v;
}
__device__ __forceinline__ void lds_barrier() { asm volatile("s_waitcnt lgkmcnt(0)" ::: "memory"); __builtin_amdgcn_s_barrier(); asm volatile("" ::: "memory"); }
__device__ __forceinline__ int opaque_tid() { int t = threadIdx.x; asm volatile("" : "+v"(t)); return t; }
__device__ __forceinline__ f32x4 mfma16(bf16x8 a, bf16x8 b, f32x4 c) { return __builtin_amdgcn_mfma_f32_16x16x32_bf16(a, b, c, 0, 0, 0); }


#define XB_TMO      128
#define XB_XCNT(j)  (256  + 64 * (j))
#define XB_XSUB(j)  (1280 + 64 * (j))
#define XB_XGEN(j)  (2304 + 64 * (j))
#define XB_TOP      3328
#define XB_TOPGEN   3392
#define XCD_BAR_WORDS 3456
#define XB_SPIN_CAP (1u << 22)
__device__ __forceinline__ unsigned xb_ld(unsigned* p)              { return __hip_atomic_load(p, __ATOMIC_RELAXED, __HIP_MEMORY_SCOPE_AGENT); }
__device__ __forceinline__ unsigned xb_add(unsigned* p, unsigned v) { return __hip_atomic_fetch_add(p, v, __ATOMIC_RELAXED, __HIP_MEMORY_SCOPE_AGENT); }
__device__ __forceinline__ unsigned xb_xcc_id() { return (unsigned)__builtin_amdgcn_s_getreg((3 << 11) | 20) & 0xFu; }
#define XB_SPIN(cond, bar) do { unsigned _sp = 0; while (cond) { __builtin_amdgcn_s_sleep(1); \
    if ((++_sp & 255u) == 0u) { if (xb_ld(&(bar)[XB_TMO])) break; if (_sp > XB_SPIN_CAP) { atomicAdd(&(bar)[XB_TMO], 1u); break; } } } } while (0)
struct XcdBarrier { unsigned* bar; unsigned x; volatile LAS unsigned* st; };
__device__ __forceinline__ XcdBarrier xcd_barrier_post(unsigned* bar, volatile LAS unsigned* st) {
    XcdBarrier b; b.bar = bar; b.x = xb_xcc_id(); b.st = st;
    if (threadIdx.x == 0) (void)xb_add(&bar[XB_XCNT(b.x)], 1u);
    return b;
}
__device__ __forceinline__ void xcd_barrier_complete(unsigned* bar, unsigned x, unsigned& nloc, unsigned& nx) {
    const unsigned G = gridDim.x * gridDim.y * gridDim.z;
    unsigned sum, cnt, mine, sp = 0u;
    for (;;) {
        sum = 0u; cnt = 0u; mine = 0u;
#pragma unroll
        for (unsigned j = 0; j < 16; ++j) { const unsigned c = xb_ld(&bar[XB_XCNT(j)]); sum += c; cnt += (c > 0u) ? 1u : 0u; mine = (j == x) ? c : mine; }
        if (sum == G) break;
        __builtin_amdgcn_s_sleep(1);
        if ((++sp & 255u) == 0u) { if (xb_ld(&bar[XB_TMO])) break; if (sp > XB_SPIN_CAP) { atomicAdd(&bar[XB_TMO], 1u); break; } }
    }
    nloc = mine > 0u ? mine : 1u; nx = cnt > 0u ? cnt : 1u;
}
__device__ __forceinline__ void xcd_barrier(const XcdBarrier& b) {
    asm volatile("s_waitcnt vmcnt(0)" ::: "memory");
    __syncthreads();
    if (threadIdx.x == 0) {
        unsigned* bar = b.bar;
        __builtin_amdgcn_s_waitcnt(0);
        unsigned nloc = b.st[0], nx = b.st[1];
        if (nloc == 0u) { xcd_barrier_complete(bar, b.x, nloc, nx); b.st[0] = nloc; b.st[1] = nx; }
        const unsigned old = xb_add(&bar[XB_XSUB(b.x)], 1u);
        const unsigned gen = old / nloc;
        if (old + 1u == (gen + 1u) * nloc) {
            __builtin_amdgcn_fence(__ATOMIC_RELEASE, "agent");
            asm volatile("s_waitcnt vmcnt(0)" ::: "memory");
            const unsigned og = xb_add(&bar[XB_TOP], 1u);
            const unsigned tg = og / nx;
            if (og + 1u == (tg + 1u) * nx) xb_add(&bar[XB_TOPGEN], 1u);
            else XB_SPIN(xb_ld(&bar[XB_TOPGEN]) == tg, bar);
            __builtin_amdgcn_fence(__ATOMIC_ACQUIRE, "agent");
            xb_add(&bar[XB_XGEN(b.x)], 1u);
            asm volatile("s_waitcnt vmcnt(0)" ::: "memory");
        } else {
            XB_SPIN(xb_ld(&bar[XB_XGEN(b.x)]) == gen, bar);
            __builtin_amdgcn_fence(__ATOMIC_ACQUIRE, "agent");
            asm volatile("s_waitcnt vmcnt(0)" ::: "memory");
        }
    }
    __syncthreads();
}

namespace pg8 {
constexpr int BM = 256, BK = 64, HALF = 128, HTB = HALF * BK * 2, STAGE_BYTES = 8 * HTB, NXCD = 8, WGM = 4;
__device__ __forceinline__ int lds_byte(int r, int c) { const int st = (r >> 4) * 2 + (c >> 5), rr = r & 15, cc = c & 31, ob = rr * 64 + cc * 2; return st * 1024 + (ob ^ (((ob >> 9) & 1) << 5)); }
__device__ __forceinline__ void stage_rc(int b, int& R, int& C) { const int st = b / 1024, sb = b % 1024, swz = sb ^ (((sb >> 9) & 1) << 5); R = (st >> 1) * 16 + swz / 64; C = (st & 1) * 32 + (swz % 64) / 2; }
__device__ __forceinline__ int perm32(int rho) { const int n = rho >> 4, i = rho & 15; return 8 * (i >> 2) + 4 * n + (i & 3); }

struct Unit { int pm, pn; };
struct Gemm { const bf16_t* A; const bf16_t* Bt; int M, N, K, lda, ldb; };

struct StaticOrder {
    int nM, nN, nwg, G, c;
    __device__ void init(int M, int N, int G_, int c_) { nM = M / BM; nN = N / BM; nwg = nM * nN; G = G_; c = c_; }
    __device__ bool next(int i, Unit& u) const {
        const long L = (long)i * G + c; if (L >= nwg) return false;
        int wgid = (int)L; { const int q = nwg / NXCD, r = nwg % NXCD, xcd = wgid % NXCD, off = wgid / NXCD; wgid = (xcd < r ? xcd * (q + 1) : r * (q + 1) + (xcd - r) * q) + off; }
        const int nig = WGM * nN, gid = wgid / nig, fm = gid * WGM, gsz = (nM - fm) < WGM ? (nM - fm) : WGM;
        u.pm = fm + ((wgid % nig) % gsz); u.pn = (wgid % nig) / gsz; return true;
    }
};


template <class Epi>
__device__ __forceinline__ void gemm_phase(LAS unsigned char* lds, const Gemm g, const StaticOrder& S, const Epi& E) {
    const int tid = opaque_tid(), wid = __builtin_amdgcn_readfirstlane(tid >> 6), lane = tid & 63, wr = wid >> 2, wc = wid & 3, fr = lane & 15, fq = lane >> 4;
    const int K = g.K, nt = K / BK;
    unsigned voffA[2], voffB[2];
#pragma unroll
    for (int i = 0; i < 2; ++i) { int R, C; stage_rc(tid * 16 + i * 8192, R, C); const int Rb = Epi::PERM ? ((R & ~31) + perm32(R & 31)) : R;
        voffA[i] = (unsigned)(R * g.lda + C) * 2u; voffB[i] = (unsigned)(Rb * g.ldb + C) * 2u; }
    const size_t kstep = (size_t)(BK * 2);
    const size_t hstepA = (size_t)HALF * g.lda * 2, hstepB = (size_t)HALF * g.ldb * 2;
    const size_t tstepA = 2 * hstepA, tstepB = 2 * hstepB;
    const unsigned ldsw = (unsigned)wid * 1024u;
    const int aoff = lds_byte(wr * 64 + fr, fq * 8), boff = lds_byte(wc * 32 + fr, fq * 8);
#define PG8_SA(b, h) (((b) * 2 + (h)) * HTB)
#define PG8_SB(b, h) ((4 + (b) * 2 + (h)) * HTB)
#define PG8_STAGE(bufoff, gbase, voff) do { _Pragma("unroll") for (int _i = 0; _i < 2; ++_i) \
        __builtin_amdgcn_global_load_lds((const unsigned*)((const char*)(gbase) + (voff)[_i]), (LAS unsigned*)(lds + (bufoff) + ldsw + _i * 8192), 16, 0, 0); } while (0)
#define PG8_LDA(dst, b, h) do { _Pragma("unroll") for (int m = 0; m < 4; ++m) _Pragma("unroll") for (int k = 0; k < 2; ++k) dst[m][k] = *(const LAS bf16x8*)(lds + PG8_SA(b, h) + aoff + m * 2048 + k * 1024); } while (0)
#define PG8_LDB(dst, b, h) do { _Pragma("unroll") for (int n = 0; n < 2; ++n) _Pragma("unroll") for (int k = 0; k < 2; ++k) dst[n][k] = *(const LAS bf16x8*)(lds + PG8_SB(b, h) + boff + n * 2048 + k * 1024); } while (0)
#define PG8_MMA(ai, bj, At, Bt) do { __builtin_amdgcn_s_setprio(1); _Pragma("unroll") for (int m = 0; m < 4; ++m) _Pragma("unroll") for (int n = 0; n < 2; ++n) _Pragma("unroll") for (int k = 0; k < 2; ++k) \
        acc[ai][bj][m][n] = __builtin_amdgcn_mfma_f32_16x16x32_bf16(Bt[n][k], At[m][k], acc[ai][bj][m][n], 0, 0, 0); __builtin_amdgcn_s_setprio(0); } while (0)
#define PG8_WAIT_V(n) asm volatile("s_waitcnt vmcnt(" #n ")" ::: "memory")
#define PG8_WAIT_L(n) asm volatile("s_waitcnt lgkmcnt(" #n ")" ::: "memory")
#define PG8_BAR __builtin_amdgcn_s_barrier()
#define PG8_SCHED __builtin_amdgcn_sched_barrier(0)
    Unit cur, nxt; int ui = 0;
    if (!S.next(0, cur)) return;
    f32x4 acc[2][2][4][2];
    if constexpr (Epi::INIT) E.init(acc, cur, wr, wc, fr, fq);
    else {
#pragma unroll
    for (int a = 0; a < 2; ++a)
#pragma unroll
        for (int b = 0; b < 2; ++b)
#pragma unroll
            for (int m = 0; m < 4; ++m)
#pragma unroll
                for (int n = 0; n < 2; ++n) acc[a][b][m][n] = (f32x4){0.f, 0.f, 0.f, 0.f};
    }
    bf16x8 At[4][2], B0[2][2], B1[2][2];
    const char* cA = (const char*)g.A + (size_t)cur.pm * tstepA; const char* cB = (const char*)g.Bt + (size_t)cur.pn * tstepB;
    PG8_STAGE(PG8_SB(0, 0), cB, voffB); PG8_STAGE(PG8_SA(0, 0), cA, voffA); PG8_STAGE(PG8_SB(0, 1), cB + hstepB, voffB); PG8_STAGE(PG8_SA(0, 1), cA + hstepA, voffA);
    if (wr == 1) PG8_BAR;
    PG8_WAIT_V(4); PG8_BAR;
    PG8_STAGE(PG8_SB(1, 0), cB + kstep, voffB); PG8_STAGE(PG8_SA(1, 0), cA + kstep, voffA); PG8_STAGE(PG8_SB(1, 1), cB + hstepB + kstep, voffB);
    PG8_WAIT_V(6); PG8_BAR;
    if constexpr (Epi::INIT) {
#pragma unroll
        for (int a = 0; a < 2; ++a)
#pragma unroll
            for (int b = 0; b < 2; ++b)
#pragma unroll
                for (int m = 0; m < 4; ++m) asm volatile("" : "+v"(acc[a][b][m][0]), "+v"(acc[a][b][m][1]));
    }
    for (;;) {
        const bool has_next = S.next(ui + 1, nxt);
        const char* nA = has_next ? (const char*)g.A + (size_t)nxt.pm * tstepA : cA; const char* nB = has_next ? (const char*)g.Bt + (size_t)nxt.pn * tstepB : cB;
        for (int t = 0; t < nt; t += 2) {
            const bool last = (t == nt - 2);
            const char* a1 = cA + (size_t)(t + 1) * kstep;
            const char* a2 = last ? nA : cA + (size_t)(t + 2) * kstep; const char* b2 = last ? nB : cB + (size_t)(t + 2) * kstep;
            const char* a3 = a2 + kstep; const char* b3 = b2 + kstep;
            PG8_LDB(B0, 0, 0); PG8_SCHED; PG8_LDA(At, 0, 0); PG8_STAGE(PG8_SA(1, 1), a1 + hstepA, voffA);
            PG8_WAIT_L(8); PG8_BAR; PG8_WAIT_L(0); PG8_MMA(0, 0, At, B0); PG8_BAR; PG8_SCHED;
            PG8_LDB(B1, 0, 1); PG8_STAGE(PG8_SB(0, 0), b2, voffB);
            PG8_BAR; PG8_WAIT_L(0); PG8_MMA(0, 1, At, B1); PG8_BAR;
            PG8_LDA(At, 0, 1); PG8_STAGE(PG8_SA(0, 0), a2, voffA);
            PG8_BAR; PG8_WAIT_L(0); PG8_MMA(1, 0, At, B0); PG8_BAR; PG8_SCHED;
            PG8_STAGE(PG8_SB(0, 1), b2 + hstepB, voffB);
            PG8_WAIT_V(6); PG8_BAR; PG8_MMA(1, 1, At, B1); PG8_BAR;
            PG8_LDB(B0, 1, 0); PG8_SCHED; PG8_LDA(At, 1, 0); PG8_STAGE(PG8_SA(0, 1), a2 + hstepA, voffA);
            PG8_WAIT_L(8); PG8_BAR; PG8_WAIT_L(0); PG8_MMA(0, 0, At, B0); PG8_BAR; PG8_SCHED;
            PG8_LDB(B1, 1, 1); PG8_STAGE(PG8_SB(1, 0), b3, voffB);
            PG8_BAR; PG8_WAIT_L(0); PG8_MMA(0, 1, At, B1); PG8_BAR;
            PG8_LDA(At, 1, 1); PG8_STAGE(PG8_SA(1, 0), a3, voffA);
            PG8_BAR; PG8_WAIT_L(0); PG8_MMA(1, 0, At, B0); PG8_BAR; PG8_SCHED;
            PG8_STAGE(PG8_SB(1, 1), b3 + hstepB, voffB);
            PG8_WAIT_V(6); PG8_BAR; PG8_MMA(1, 1, At, B1); PG8_BAR;
        }
        if constexpr (!Epi::AFTER_DRAIN) { E(acc, cur, ui, wr, wc, fr, fq); }
        if (!has_next) break;
#pragma unroll
        for (int a = 0; a < 2; ++a)
#pragma unroll
            for (int b = 0; b < 2; ++b)
#pragma unroll
                for (int m = 0; m < 4; ++m)
#pragma unroll
                    for (int n = 0; n < 2; ++n) acc[a][b][m][n] = (f32x4){0.f, 0.f, 0.f, 0.f};
        cur = nxt; cA = nA; cB = nB; ++ui;
    }
    PG8_WAIT_V(0);
    if (wr == 0) PG8_BAR;
    PG8_BAR;
    if constexpr (Epi::AFTER_DRAIN) { E.fused(acc, cur, wr, wc, fr, fq, lds, wid, lane); }
#undef PG8_SA
#undef PG8_SB
#undef PG8_STAGE
#undef PG8_LDA
#undef PG8_LDB
#undef PG8_MMA
#undef PG8_WAIT_V
#undef PG8_WAIT_L
#undef PG8_BAR
#undef PG8_SCHED
}

struct EpiBf16Scale {
    static constexpr bool PERM = true, AFTER_DRAIN = false, INIT = false;
    bf16_t* O; int ldc; const float* colscale;
    __device__ __forceinline__ void operator()(const f32x4 (&acc)[2][2][4][2], const Unit& u, int ui, int wr, int wc, int fr, int fq) const {
        const int row0 = u.pm * BM + wr * 64 + fr, col0 = u.pn * BM + wc * 32 + 8 * fq;
        f32x4 sv[2][2];
#pragma unroll
        for (int bj = 0; bj < 2; ++bj)
#pragma unroll
            for (int n = 0; n < 2; ++n) sv[bj][n] = colscale ? *(const f32x4*)(colscale + col0 + bj * HALF + 4 * n) : (f32x4){1.f, 1.f, 1.f, 1.f};
#pragma unroll
        for (int ai = 0; ai < 2; ++ai)
#pragma unroll
            for (int m = 0; m < 4; ++m) { bf16_t* rowp = O + (size_t)(row0 + ai * HALF + m * 16) * ldc + col0;
#pragma unroll
                for (int bj = 0; bj < 2; ++bj) { const f32x4 v0 = acc[ai][bj][m][0] * sv[bj][0], v1 = acc[ai][bj][m][1] * sv[bj][1];
                    u32x4 w; w.x = cvt_pk_bf16(v0[0], v0[1]); w.y = cvt_pk_bf16(v0[2], v0[3]); w.z = cvt_pk_bf16(v1[0], v1[1]); w.w = cvt_pk_bf16(v1[2], v1[3]);
                    *(u32x4*)(rowp + bj * HALF) = w; } }
    }
};
struct EpiSqRelu {
    static constexpr bool PERM = true, AFTER_DRAIN = false, INIT = false;
    bf16_t* O; int ldc; const LAS float* rl;
    __device__ __forceinline__ void operator()(const f32x4 (&acc)[2][2][4][2], const Unit& u, int ui, int wr, int wc, int fr, int fq) const {
        const int row0 = u.pm * BM + wr * 64 + fr, col0 = u.pn * BM + wc * 32 + 8 * fq;
#pragma unroll
        for (int ai = 0; ai < 2; ++ai)
#pragma unroll
            for (int m = 0; m < 4; ++m) { const int rloc = wr * 64 + fr + ai * HALF + m * 16; const int row = u.pm * BM + rloc;
                const float rstd = rl[ui * 256 + rloc];
                bf16_t* rowp = O + (size_t)row * ldc + col0;
#pragma unroll
                for (int bj = 0; bj < 2; ++bj) { f32x4 v0 = acc[ai][bj][m][0] * rstd, v1 = acc[ai][bj][m][1] * rstd;
#pragma unroll
                    for (int j = 0; j < 4; ++j) { const float a = fmaxf(v0[j], 0.f), b = fmaxf(v1[j], 0.f); v0[j] = a * a; v1[j] = b * b; }
                    u32x4 w; w.x = cvt_pk_bf16(v0[0], v0[1]); w.y = cvt_pk_bf16(v0[2], v0[3]); w.z = cvt_pk_bf16(v1[0], v1[1]); w.w = cvt_pk_bf16(v1[2], v1[3]);
                    *(u32x4*)(rowp + bj * HALF) = w; } }
    }
};
struct EpiResid {
    static constexpr bool PERM = false, AFTER_DRAIN = true, INIT = true;
    const float* base; float* out; bf16_t* outb; int ldc; float* ssp;
    __device__ __forceinline__ void init(f32x4 (&acc)[2][2][4][2], const Unit& u, int wr, int wc, int fr, int fq) const {
        const int col0 = u.pn * BM + wc * 32 + 4 * fq;
#pragma unroll
        for (int ai = 0; ai < 2; ++ai)
#pragma unroll
            for (int m = 0; m < 4; ++m) { const size_t off = (size_t)(u.pm * BM + ai * HALF + wr * 64 + m * 16 + fr) * ldc + col0;
#pragma unroll
                for (int bj = 0; bj < 2; ++bj)
#pragma unroll
                    for (int n = 0; n < 2; ++n) acc[ai][bj][m][n] = __builtin_nontemporal_load((const f32x4*)(base + off + bj * HALF + n * 16)); }
    }
    __device__ __forceinline__ void fused(f32x4 (&acc)[2][2][4][2], const Unit& u, int wr, int wc, int fr, int fq, LAS unsigned char* lds, int wid, int lane) const {
        LAS float* P = (LAS float*)lds;
        const int col0 = u.pn * BM + wc * 32 + 4 * fq;
#pragma unroll
        for (int ai = 0; ai < 2; ++ai)
#pragma unroll
            for (int m = 0; m < 4; ++m) { const int r = ai * HALF + wr * 64 + m * 16 + fr; const size_t off = (size_t)(u.pm * BM + r) * ldc + col0; float s = 0.f;
#pragma unroll
                for (int bj = 0; bj < 2; ++bj)
#pragma unroll
                    for (int n = 0; n < 2; ++n) { const f32x4 o = acc[ai][bj][m][n];
                        if (out) *(f32x4*)(out + off + bj * HALF + n * 16) = o;
                        if (outb) { u32x2 w; w.x = cvt_pk_bf16(o[0], o[1]); w.y = cvt_pk_bf16(o[2], o[3]); *(u32x2*)(outb + off + bj * HALF + n * 16) = w; }
                        s += (o[0] * o[0] + o[1] * o[1]) + (o[2] * o[2] + o[3] * o[3]); }
                s += __shfl_xor(s, 16); s += __shfl_xor(s, 32);
                if (fq == 0) P[r * 4 + wc] = s;
                asm volatile("" ::: "memory"); }
        __syncthreads();
        const int tid = wid * 64 + lane;
        if (tid < 256) { const float s = (P[tid * 4 + 0] + P[tid * 4 + 1]) + (P[tid * 4 + 2] + P[tid * 4 + 3]); ssp[(size_t)(u.pm * BM + tid) * 8 + u.pn] = s; }
        __syncthreads();
    }
};

struct EpiFinal {
    static constexpr bool PERM = false, AFTER_DRAIN = true, INIT = true;
    float* out; int ldc; float* ssp; unsigned* cnt; const float* fnw; const bf16_t* hb;
    __device__ __forceinline__ void init(f32x4 (&acc)[2][2][4][2], const Unit& u, int wr, int wc, int fr, int fq) const {
        const int col0 = u.pn * BM + wc * 32 + 4 * fq;
#pragma unroll
        for (int ai = 0; ai < 2; ++ai)
#pragma unroll
            for (int m = 0; m < 4; ++m) { const size_t off = (size_t)(u.pm * BM + ai * HALF + wr * 64 + m * 16 + fr) * ldc + col0;
#pragma unroll
                for (int bj = 0; bj < 2; ++bj)
#pragma unroll
                    for (int n = 0; n < 2; ++n) { const u32x2 w = __builtin_nontemporal_load((const u32x2*)(hb + off + bj * HALF + n * 16)); acc[ai][bj][m][n] = (f32x4){__uint_as_float(w.x << 16), __uint_as_float(w.x & 0xffff0000u), __uint_as_float(w.y << 16), __uint_as_float(w.y & 0xffff0000u)}; } }
    }
    __device__ __forceinline__ void fused(f32x4 (&acc)[2][2][4][2], const Unit& u, int wr, int wc, int fr, int fq, LAS unsigned char* lds, int wid, int lane) const {
        LAS float* P = (LAS float*)lds;
        LAS float* R = (LAS float*)(lds + 4096);
        const int col0 = u.pn * BM + wc * 32 + 4 * fq;
#pragma unroll
        for (int ai = 0; ai < 2; ++ai)
#pragma unroll
            for (int m = 0; m < 4; ++m) { const int r = ai * HALF + wr * 64 + m * 16 + fr; const size_t off = (size_t)(u.pm * BM + r) * ldc + col0; float s = 0.f;
#pragma unroll
                for (int bj = 0; bj < 2; ++bj)
#pragma unroll
                    for (int n = 0; n < 2; ++n) { const f32x4 o = acc[ai][bj][m][n];
                        s += (o[0] * o[0] + o[1] * o[1]) + (o[2] * o[2] + o[3] * o[3]); }
                s += __shfl_xor(s, 16); s += __shfl_xor(s, 32);
                if (fq == 0) P[r * 4 + wc] = s;
                asm volatile("" ::: "memory"); }
        __syncthreads();
        const int tid = wid * 64 + lane;
        float* slot = ssp + (size_t)(u.pm * BM + (tid & 255)) * 8;
        if (tid < 256) { const float s = (P[tid * 4 + 0] + P[tid * 4 + 1]) + (P[tid * 4 + 2] + P[tid * 4 + 3]); __hip_atomic_store(slot + u.pn, s, __ATOMIC_RELAXED, __HIP_MEMORY_SCOPE_AGENT); }
        asm volatile("s_waitcnt vmcnt(0)" ::: "memory");
        __syncthreads();
        if (tid == 0) {
            unsigned* c = cnt + 64 * u.pm;
            __hip_atomic_fetch_add(c, 1u, __ATOMIC_RELAXED, __HIP_MEMORY_SCOPE_AGENT);
            unsigned sp = 0;
            while (__hip_atomic_load(c, __ATOMIC_RELAXED, __HIP_MEMORY_SCOPE_AGENT) < 8u) { __builtin_amdgcn_s_sleep(1); if (++sp > (1u << 24)) break; }
            __builtin_amdgcn_fence(__ATOMIC_ACQUIRE, "agent");
            asm volatile("s_waitcnt vmcnt(0)" ::: "memory");
        }
        __syncthreads();
        if (tid < 256) { float ss = 0.f;
#pragma unroll
            for (int j = 0; j < 8; ++j) ss += __hip_atomic_load(slot + j, __ATOMIC_RELAXED, __HIP_MEMORY_SCOPE_AGENT);
            R[tid] = 1.0f / sqrtf(ss * (1.0f / DM) + EPS); }
        __syncthreads();
#pragma unroll
        for (int ai = 0; ai < 2; ++ai)
#pragma unroll
            for (int m = 0; m < 4; ++m) { const int r = ai * HALF + wr * 64 + m * 16 + fr; const size_t off = (size_t)(u.pm * BM + r) * ldc + col0; const float rs = R[r];
#pragma unroll
                for (int bj = 0; bj < 2; ++bj)
#pragma unroll
                    for (int n = 0; n < 2; ++n) { const f32x4 fw = *(const f32x4*)(fnw + col0 + bj * HALF + n * 16); *(f32x4*)(out + off + bj * HALF + n * 16) = acc[ai][bj][m][n] * rs * fw; } }
    }
};
}

__device__ __forceinline__ int win_map(int n) { return n < 3072 ? n : (n < 3088 ? n + 1024 : n - 16); }
struct P0Desc { const float* src; const float* scale; bf16_t* dst; int ldn, K, n0, N, k0, map, ldk; };
__device__ __forceinline__ P0Desc p0_decode(const Params& p, unsigned char* ws, int it) {
    constexpr int I_1 = 32 * 128, I_2 = 128 * 32, I_IN = 32 * 65, I_OUT = 32 * 32;
    P0Desc d; int r = it, nblk;
    if (r < I_1) { d.src = p.mlp_w1; d.scale = p.norm2_w; d.dst = (bf16_t*)(ws + OFF_W1T); d.ldn = DFF; d.K = DM; d.N = DFF; d.map = 0; nblk = 128; }
    else if ((r -= I_1) < I_2) { d.src = p.mlp_w2; d.scale = nullptr; d.dst = (bf16_t*)(ws + OFF_W2T); d.ldn = DM; d.K = DFF; d.N = DM; d.map = 0; nblk = 32; }
    else if ((r -= I_2) < I_IN) { d.src = p.w_in; d.scale = p.norm1_w; d.dst = (bf16_t*)(ws + OFF_WINT); d.ldn = DIN; d.K = DM; d.N = DIN; d.map = 1; nblk = 65; }
    else if ((r -= I_IN) < I_OUT) { d.src = p.w_out; d.scale = nullptr; d.dst = (bf16_t*)(ws + OFF_WOUTT); d.ldn = DM; d.K = DM; d.N = DM; d.map = 0; nblk = 32; }
    else { r -= I_OUT; const int g = r >> 4; r &= 15; d.src = p.pool_w + (size_t)g * 65536; d.scale = nullptr; d.dst = (bf16_t*)(ws + OFF_POOLWT) + (size_t)g * 65536; d.ldn = 256; d.K = 256; d.N = 256; d.map = 0; nblk = 4; }
    d.ldk = d.map ? XLD : d.K;
    const int nkb = d.K >> 6; const int nb = r / nkb, kb = r - nb * nkb; d.k0 = kb * 64; d.n0 = nb * 64;
    return d;
}
#define P0_LOAD(d, v) do { const int _n = (d).n0 + lane; const float* _s = (d).src + (size_t)(d).k0 * (d).ldn + (_n < (d).N ? _n : 0); \
    _Pragma("unroll") for (int _i = 0; _i < 64; ++_i) v[_i] = __builtin_nontemporal_load(_s + (size_t)_i * (d).ldn); } while (0)
__device__ __forceinline__ void p0_rows2(const float* r0, const float* r1, bf16_t* o0, bf16_t* o1, bool two, int lane) {
    const f32x4* x0 = (const f32x4*)r0 + lane; const f32x4* x1 = (const f32x4*)r1 + lane; f32x4 v[8], w[8]; float s0 = 0.f, s1 = 0.f;
#pragma unroll
    for (int j = 0; j < 8; ++j) v[j] = __builtin_nontemporal_load(x0 + 64 * j);
    if (two) {
#pragma unroll
        for (int j = 0; j < 8; ++j) w[j] = __builtin_nontemporal_load(x1 + 64 * j);
    } else {
#pragma unroll
        for (int j = 0; j < 8; ++j) w[j] = (f32x4){0.f, 0.f, 0.f, 0.f};
    }
#pragma unroll
    for (int j = 0; j < 8; ++j) { s0 += (v[j][0] * v[j][0] + v[j][1] * v[j][1]) + (v[j][2] * v[j][2] + v[j][3] * v[j][3]); s1 += (w[j][0] * w[j][0] + w[j][1] * w[j][1]) + (w[j][2] * w[j][2] + w[j][3] * w[j][3]); }
    const float rs0 = 1.0f / sqrtf(wave_sum(s0) * (1.0f / DM) + EPS), rs1 = 1.0f / sqrtf(wave_sum(s1) * (1.0f / DM) + EPS);
    u32x2* q0 = (u32x2*)o0 + lane; u32x2* q1 = (u32x2*)o1 + lane;
#pragma unroll
    for (int j = 0; j < 8; ++j) { u32x2 t; t.x = cvt_pk_bf16(v[j][0] * rs0, v[j][1] * rs0); t.y = cvt_pk_bf16(v[j][2] * rs0, v[j][3] * rs0); q0[64 * j] = t; }
    if (two) {
#pragma unroll
        for (int j = 0; j < 8; ++j) { u32x2 t; t.x = cvt_pk_bf16(w[j][0] * rs1, w[j][1] * rs1); t.y = cvt_pk_bf16(w[j][2] * rs1, w[j][3] * rs1); q1[64 * j] = t; }
    }
}
__device__ __forceinline__ void phase0(const Params& p, unsigned char* lds) {
    const int tid = opaque_tid(), lane = tid & 63, wave = tid >> 6;
    LAS float* scr = (LAS float*)((LAS unsigned char*)lds + wave * 16640);
    const int gw = blockIdx.x * 8 + wave, NGW = NBLK * 8;
    unsigned char* ws = p.ws;
    constexpr int NITEMS = 32 * 128 + 128 * 32 + 32 * 65 + 32 * 32 + 4 * 16;
    float v[64];
    int it = (int)(((long)gw * NITEMS) / NGW); const int it_end = (int)(((long)(gw + 1) * NITEMS) / NGW);
    P0Desc d = p0_decode(p, ws, it < it_end ? it : 0);
    if (it < it_end) P0_LOAD(d, v);
    while (it < it_end) {
        const bool ok = d.n0 + lane < d.N;
#pragma unroll
        for (int i = 0; i < 64; ++i) { const float sc = d.scale ? d.scale[d.k0 + i] : 1.0f; scr[i * 65 + lane] = ok ? v[i] * sc : 0.f; }
        asm volatile("s_waitcnt lgkmcnt(0)" ::: "memory"); __builtin_amdgcn_wave_barrier();
        const P0Desc c = d;
        it += 1;
        if (it < it_end) { d = p0_decode(p, ws, it); P0_LOAD(d, v); }
#pragma unroll
        for (int j = 0; j < 8; ++j) { const int pc = lane + 64 * j, nn = pc >> 3, cc = pc & 7; const LAS float* s = scr + (8 * cc) * 65 + nn;
            u32x4 o; o.x = cvt_pk_bf16(s[0], s[65]); o.y = cvt_pk_bf16(s[2 * 65], s[3 * 65]); o.z = cvt_pk_bf16(s[4 * 65], s[5 * 65]); o.w = cvt_pk_bf16(s[6 * 65], s[7 * 65]);
            const int ng = c.n0 + nn;
            if (ng < c.N) { const int row = c.map ? win_map(ng) : ng; *(u32x4*)(c.dst + (size_t)row * c.ldk + c.k0 + 8 * cc) = o; } }
        asm volatile("s_waitcnt lgkmcnt(0)" ::: "memory"); __builtin_amdgcn_wave_barrier();
    }
    {
        bf16_t* xb = (bf16_t*)(ws + OFF_XB);
        const int r0 = 1024 * (blockIdx.x & 7) + ((blockIdx.x >> 3) * 8 + wave);
#pragma unroll 1
        for (int i = 0; i < 4; i += 2) { const int m = r0 + 256 * i, m2 = m + 256;
            p0_rows2(p.x + (size_t)m * DM, p.x + (size_t)m2 * DM, xb + (size_t)m * XLD, xb + (size_t)m2 * XLD, true, lane); }
        if (gw < NMETA) { const float* sm = p.meta + (size_t)gw * DM; bf16_t* om = xb + (size_t)(MR + gw) * XLD; p0_rows2(sm, sm, om, om, false, lane); }
    }
}

__device__ __forceinline__ void phase1_skinny(const Params& p, unsigned char* lds) {
    const int tid = opaque_tid(), lane = tid & 63, wave = tid >> 6;
    unsigned char* ws = p.ws;
    const bf16_t* xb = (const bf16_t*)(ws + OFF_XB); const bf16_t* wint = (const bf16_t*)(ws + OFF_WINT);
    f32x4* red = (f32x4*)lds;
#pragma unroll 1
    for (int task = blockIdx.x; task < 513 + 256; task += NBLK) {
        const bf16_t* Mrows = task < 513 ? xb + (size_t)task * 16 * XLD : xb + (size_t)MR * XLD;
        const bf16_t* Nrows = task < 513 ? wint + (size_t)4096 * XLD : wint + (size_t)(task - 513) * 16 * XLD;
        const bf16x8* mp = (const bf16x8*)(Mrows + (size_t)(lane & 15) * XLD + wave * 256 + 8 * (lane >> 4));
        const bf16x8* np = (const bf16x8*)(Nrows + (size_t)(lane & 15) * XLD + wave * 256 + 8 * (lane >> 4));
        bf16x8 mf[8], nf[8];
#pragma unroll
        for (int kk = 0; kk < 8; ++kk) { mf[kk] = mp[kk * 4]; nf[kk] = np[kk * 4]; }
        f32x4 a = {0.f, 0.f, 0.f, 0.f};
#pragma unroll
        for (int kk = 0; kk < 8; ++kk) a = mfma16(nf[kk], mf[kk], a);
        red[wave * 64 + lane] = a;
        lds_barrier();
        if (wave == 0) {
            f32x4 sacc = red[lane];
#pragma unroll
            for (int w = 1; w < 8; ++w) sacc += red[w * 64 + lane];
            if (task < 513) *(f32x4*)((float*)(ws + OFF_GLR) + (size_t)(task * 16 + (lane & 15)) * 16 + 4 * (lane >> 4)) = sacc;
            else { u32x2 w; w.x = cvt_pk_bf16(sacc[0], sacc[1]); w.y = cvt_pk_bf16(sacc[2], sacc[3]);
                *(u32x2*)((bf16_t*)(ws + OFF_PROJ) + (size_t)(MR + (lane & 15)) * PLD + (task - 513) * 16 + 4 * (lane >> 4)) = w; }
        }
        lds_barrier();
    }
}

constexpr int L_GLR = 0, L_W2 = 4096, L_GSUM = 12288, L_QD = 14336, L_KI = 31744, L_KET = 49152, L_VT = 67584, L_P = 104448;
struct GlaIn { bf16_t qv[16], kv[16], vv[32]; f32x4 glrv, w2v; float gb; };
__device__ __forceinline__ void gla_a_load(const Params& p, int u, GlaIn& r) {
    const int tid = opaque_tid();
    unsigned char* ws = p.ws;
    const bool meta = u >= 512;
    const int h = meta ? (u - 512) : ((u >> 5) & 3);
    const int row0 = meta ? MR : ((u >> 7) * 2048 + (u & 31) * 64);
    const int nvalid = meta ? NMETA : 64;
    const bf16_t* proj = (const bf16_t*)(ws + OFF_PROJ);
    const float* glr = (const float*)(ws + OFF_GLR);
    const int d = tid & 127, tq = tid >> 7, dvc = tid & 255, th = tid >> 8;
#pragma unroll
    for (int i = 0; i < 16; ++i) { const int t = tq * 16 + i, tc = t < nvalid ? t : nvalid - 1; const bf16_t* pr = proj + (size_t)(row0 + tc) * PLD + h * 128 + d; r.qv[i] = __builtin_nontemporal_load(pr); r.kv[i] = __builtin_nontemporal_load(pr + 512); }
#pragma unroll
    for (int i = 0; i < 32; ++i) { const int t = th * 32 + i, tc = t < nvalid ? t : nvalid - 1; r.vv[i] = __builtin_nontemporal_load(proj + (size_t)(row0 + tc) * PLD + 1024 + h * 256 + dvc); }
    r.gb = p.gate_b[h * 128 + d];
    { const int rr = (tid & 255) >> 2, part = tid & 3, rc = rr < nvalid ? rr : nvalid - 1; r.glrv = *(const f32x4*)(glr + (size_t)(row0 + rc) * 16 + part * 4); }
    { const int idx = tid * 4, j = idx >> 7, dd = idx & 127; r.w2v = *(const f32x4*)(p.gate_w2 + j * 512 + h * 128 + dd); }
}
__device__ __forceinline__ void gla_a_compute(const Params& p, unsigned char* lds, int u, const GlaIn& r) {
    const int tid = opaque_tid(), lane = tid & 63, wave = tid >> 6, fr = lane & 15, fq = lane >> 4;
    unsigned char* ws = p.ws;
    const bool meta = u >= 512;
    const int h = meta ? (u - 512) : ((u >> 5) & 3);
    const int row0 = meta ? MR : ((u >> 7) * 2048 + (u & 31) * 64);
    const int nvalid = meta ? NMETA : 64;
    bf16_t* proj = (bf16_t*)(ws + OFF_PROJ);
    float* glr_s = (float*)(lds + L_GLR); float* w2_s = (float*)(lds + L_W2); float* gsum = (float*)(lds + L_GSUM);
    bf16_t* qd_s = (bf16_t*)(lds + L_QD); bf16_t* ki_s = (bf16_t*)(lds + L_KI); bf16_t* ket_s = (bf16_t*)(lds + L_KET); bf16_t* vt_s = (bf16_t*)(lds + L_VT);
    const int d = tid & 127, tq = tid >> 7, dvc = tid & 255, th = tid >> 8;
    const float gb = r.gb;
    if (tid < 256) { const int rr = tid >> 2, part = tid & 3; *(f32x4*)(glr_s + rr * 16 + part * 4) = rr < nvalid ? r.glrv : (f32x4){0.f, 0.f, 0.f, 0.f}; }
    *(f32x4*)(w2_s + tid * 4) = r.w2v;
    lds_barrier();
    {
        float w2c[16];
#pragma unroll
        for (int j = 0; j < 16; ++j) w2c[j] = w2_s[j * 128 + d];
        float G[16]; float run = 0.f;
#pragma unroll
        for (int i = 0; i < 16; ++i) { const int t = tq * 16 + i; const float* gr = glr_s + t * 16; float g = gb;
#pragma unroll
            for (int j = 0; j < 16; ++j) g += gr[j] * w2c[j];
            float lg = (fminf(g, 0.f) - __logf(1.0f + __expf(-fabsf(g)))) * (1.0f / 16.0f);
            if (t >= nvalid) lg = 0.f;
            run += lg; G[i] = run; }
        gsum[tq * 128 + d] = run;
        lds_barrier();
        float off = 0.f, tot = 0.f;
#pragma unroll
        for (int q = 0; q < 4; ++q) { const float sg = gsum[q * 128 + d]; tot += sg; if (q < tq) off += sg; }
#pragma unroll
        for (int i = 0; i < 16; ++i) { const int t = tq * 16 + i; const float Gt = off + G[i];
            const float q = t < nvalid ? bf2f(r.qv[i]) : 0.f, k = t < nvalid ? bf2f(r.kv[i]) : 0.f;
            const bf16_t qdb = f2bf(q * 0.08838834764831845f * __expf(Gt));
            qd_s[t * 136 + d] = qdb; ki_s[t * 136 + d] = f2bf(k * __expf(-Gt)); ket_s[d * 72 + t] = f2bf(k * __expf(tot - Gt));
            if (!meta) proj[(size_t)(row0 + t) * PLD + h * 128 + d] = qdb; }
        if (tq == 0) ((float*)(ws + OFF_DECAY))[u * 128 + d] = __expf(tot);
    }
#pragma unroll
    for (int i = 0; i < 32; ++i) { const int t = th * 32 + i; vt_s[dvc * 72 + t] = t < nvalid ? r.vv[i] : (bf16_t)0; }
    lds_barrier();
    if (!meta) {
#pragma unroll
        for (int ii = 0; ii < 2; ++ii) { const int idx = 2 * wave + ii, tt = idx >> 2, ss = idx & 3; f32x4 acc = {0.f, 0.f, 0.f, 0.f};
            if (ss <= tt) {
#pragma unroll
                for (int kk = 0; kk < 4; ++kk) { const bf16x8 mf = *(const bf16x8*)(lds + L_QD + (tt * 16 + fr) * 272 + (kk * 32 + 8 * fq) * 2);
                    const bf16x8 nf = *(const bf16x8*)(lds + L_KI + (ss * 16 + fr) * 272 + (kk * 32 + 8 * fq) * 2); acc = mfma16(nf, mf, acc); } }
            const int t = tt * 16 + fr, s0 = ss * 16 + 4 * fq;
#pragma unroll
            for (int j = 0; j < 4; ++j) if (s0 + j > t) acc[j] = 0.f;
            u32x2 w; w.x = cvt_pk_bf16(acc[0], acc[1]); w.y = cvt_pk_bf16(acc[2], acc[3]);
            *(u32x2*)(lds + L_P + t * 144 + s0 * 2) = w; }
    }
    lds_barrier();
    if (!meta) {
        f32x4 o[4][2];
#pragma unroll
        for (int tt = 0; tt < 4; ++tt) { o[tt][0] = (f32x4){0.f, 0.f, 0.f, 0.f}; o[tt][1] = (f32x4){0.f, 0.f, 0.f, 0.f}; }
#pragma unroll
        for (int kk = 0; kk < 2; ++kk) { bf16x8 nf[2];
#pragma unroll
            for (int dd = 0; dd < 2; ++dd) nf[dd] = *(const bf16x8*)(lds + L_VT + (wave * 32 + dd * 16 + fr) * 144 + (kk * 32 + 8 * fq) * 2);
#pragma unroll
            for (int tt = 0; tt < 4; ++tt) { const bf16x8 mf = *(const bf16x8*)(lds + L_P + (tt * 16 + fr) * 144 + (kk * 32 + 8 * fq) * 2);
                o[tt][0] = mfma16(nf[0], mf, o[tt][0]); o[tt][1] = mfma16(nf[1], mf, o[tt][1]); } }
        u32x2* dump = (u32x2*)(ws + OFF_OINTRA) + ((size_t)(u * 8 + wave) * 8) * 64 + lane;
#pragma unroll
        for (int tt = 0; tt < 4; ++tt)
#pragma unroll
            for (int dd = 0; dd < 2; ++dd) { u32x2 w; w.x = cvt_pk_bf16(o[tt][dd][0], o[tt][dd][1]); w.y = cvt_pk_bf16(o[tt][dd][2], o[tt][dd][3]); dump[(tt * 2 + dd) * 64] = w; }
    }
    {
        bf16_t* dsb = meta ? (bf16_t*)(ws + OFF_DSMETA) + (size_t)h * 32768 : (bf16_t*)p.out + (size_t)u * 32768;
#pragma unroll
        for (int dvt = 0; dvt < 2; ++dvt) { f32x4 acc[8];
#pragma unroll
            for (int i = 0; i < 8; ++i) acc[i] = (f32x4){0.f, 0.f, 0.f, 0.f};
#pragma unroll
            for (int kk = 0; kk < 2; ++kk) { const bf16x8 mf = *(const bf16x8*)(lds + L_VT + (wave * 32 + dvt * 16 + fr) * 144 + (kk * 32 + 8 * fq) * 2);
#pragma unroll
                for (int dkt = 0; dkt < 8; ++dkt) { const bf16x8 nf = *(const bf16x8*)(lds + L_KET + (dkt * 16 + fr) * 144 + (kk * 32 + 8 * fq) * 2); acc[dkt] = mfma16(nf, mf, acc[dkt]); } }
            bf16_t* dst = dsb + (size_t)(wave * 32 + dvt * 16 + fr) * 128 + 4 * fq;
#pragma unroll
            for (int dkt = 0; dkt < 8; ++dkt) { u32x2 w; w.x = cvt_pk_bf16(acc[dkt][0], acc[dkt][1]); w.y = cvt_pk_bf16(acc[dkt][2], acc[dkt][3]); *(u32x2*)(dst + dkt * 16) = w; } }
    }
    lds_barrier();
}
template <int W>
__device__ __forceinline__ void pool_y_rows(const bf16_t* __restrict__ proj, bf16_t* __restrict__ mixed, int b, int t0, int ch0) {
    u32x4 rows[8 + W];
#pragma unroll
    for (int i = 0; i < 8 + W; ++i) { const int tt = t0 - W + i; const size_t row = tt >= 0 ? (size_t)b * 2048 + tt : (size_t)(MR + NMETA + tt);
        rows[i] = __builtin_nontemporal_load((const u32x4*)(proj + row * PLD + 3072 + ch0)); }
    float sum[8];
#pragma unroll
    for (int e = 0; e < 8; ++e) sum[e] = 0.f;
#define POOL_UNPK(v, dst) do { dst[0] = __uint_as_float((v).x << 16); dst[1] = __uint_as_float((v).x & 0xffff0000u); dst[2] = __uint_as_float((v).y << 16); dst[3] = __uint_as_float((v).y & 0xffff0000u); \
        dst[4] = __uint_as_float((v).z << 16); dst[5] = __uint_as_float((v).z & 0xffff0000u); dst[6] = __uint_as_float((v).w << 16); dst[7] = __uint_as_float((v).w & 0xffff0000u); } while (0)
#pragma unroll
    for (int i = 1; i < W; ++i) { float v[8]; POOL_UNPK(rows[i], v);
#pragma unroll
        for (int e = 0; e < 8; ++e) sum[e] += v[e]; }
    constexpr float inv = 1.0f / (float)W;
#pragma unroll
    for (int i = 0; i < 8; ++i) { float nv[8]; POOL_UNPK(rows[W + i], nv);
        float y[8];
#pragma unroll
        for (int e = 0; e < 8; ++e) { sum[e] += nv[e]; y[e] = sum[e] * inv - nv[e]; }
        float ov[8]; POOL_UNPK(rows[i + 1], ov);
#pragma unroll
        for (int e = 0; e < 8; ++e) sum[e] -= ov[e];
        u32x4 o; o.x = cvt_pk_bf16(y[0], y[1]); o.y = cvt_pk_bf16(y[2], y[3]); o.z = cvt_pk_bf16(y[4], y[5]); o.w = cvt_pk_bf16(y[6], y[7]);
        *(u32x4*)(mixed + ((size_t)b * 2048 + t0 + i) * DM + ch0) = o; }
#undef POOL_UNPK
}
__device__ __forceinline__ void pool_y_task(const Params& p, int task) {
    const int tid = opaque_tid(), lane = tid & 63, wave = tid >> 6, g = wave >> 1;
    const int ch0 = g * 256 + (lane & 31) * 8;
    const int b = task >> 6, t0 = (task & 63) * 32 + (wave & 1) * 16 + (lane >> 5) * 8;
    const bf16_t* proj = (const bf16_t*)(p.ws + OFF_PROJ); bf16_t* mixed = (bf16_t*)(p.ws + OFF_MIXED);
    if (g == 0) pool_y_rows<2>(proj, mixed, b, t0, ch0);
    else if (g == 1) pool_y_rows<4>(proj, mixed, b, t0, ch0);
    else if (g == 2) pool_y_rows<8>(proj, mixed, b, t0, ch0);
    else pool_y_rows<16>(proj, mixed, b, t0, ch0);
}

__device__ __forceinline__ void gla_scan(const Params& p, const int e) {
    unsigned char* ws = p.ws;
    const int bh = e >> 13, rem = e & 8191, h = bh & 3;
    const size_t eo = (size_t)rem * 4;
    const int dk4 = (rem & 31) * 4;
    const u32x2 sm0 = *(const u32x2*)((const bf16_t*)(ws + OFF_DSMETA) + (size_t)h * 32768 + eo);
    f32x4 S = {__uint_as_float(sm0.x << 16), __uint_as_float(sm0.x & 0xffff0000u), __uint_as_float(sm0.y << 16), __uint_as_float(sm0.y & 0xffff0000u)};
    const bf16_t* ds = (const bf16_t*)p.out + (size_t)bh * 32 * 32768 + eo;
    const float* dec = (const float*)(ws + OFF_DECAY) + (size_t)bh * 32 * 128 + dk4;
    bf16_t* sp = (bf16_t*)(ws + OFF_SPREV) + (size_t)bh * 31 * 32768 + eo;
    bf16_t* sm = (bf16_t*)(ws + OFF_SMETAB) + (size_t)h * 32768 + eo;
    u32x2 d0[8], d1[8]; f32x4 a0[8], a1[8];
#define SCAN_LD(db, ab, c0) do { _Pragma("unroll") for (int _j = 0; _j < 8; ++_j) { db[_j] = __builtin_nontemporal_load((const u32x2*)(ds + (size_t)((c0) + _j) * 32768)); ab[_j] = *(const f32x4*)(dec + ((c0) + _j) * 128); } } while (0)
#define SCAN_DO(db, ab, c0) do { _Pragma("unroll") for (int _j = 0; _j < 8; ++_j) { const int _c = (c0) + _j; u32x2 _w; _w.x = cvt_pk_bf16(S[0], S[1]); _w.y = cvt_pk_bf16(S[2], S[3]); \
        if (_c == 0) { if (bh < 4) *(u32x2*)sm = _w; } else *(u32x2*)(sp + (size_t)(_c - 1) * 32768) = _w; \
        const f32x4 _d = {__uint_as_float(db[_j].x << 16), __uint_as_float(db[_j].x & 0xffff0000u), __uint_as_float(db[_j].y << 16), __uint_as_float(db[_j].y & 0xffff0000u)}; \
        S = ab[_j] * S + _d; } } while (0)
    SCAN_LD(d0, a0, 0); SCAN_LD(d1, a1, 8);
    SCAN_DO(d0, a0, 0); SCAN_LD(d0, a0, 16);
    SCAN_DO(d1, a1, 8); SCAN_LD(d1, a1, 24);
    SCAN_DO(d0, a0, 16);
    SCAN_DO(d1, a1, 24);
#undef SCAN_LD
#undef SCAN_DO
}

__device__ __forceinline__ void gla_c_unit(const Params& p, unsigned char* lds, int u) {
    const int tid = opaque_tid(), lane = tid & 63, wave = tid >> 6, fr = lane & 15, fq = lane >> 4;
    unsigned char* ws = p.ws;
    const int h = (u >> 5) & 3, row0 = (u >> 7) * 2048 + (u & 31) * 64;
    const bf16_t* proj = (const bf16_t*)(ws + OFF_PROJ);
    f32x4 o[4][2];
    const u32x2* dump = (const u32x2*)(ws + OFF_OINTRA) + ((size_t)(u * 8 + wave) * 8) * 64 + lane;
    const bf16_t* qbase = proj + (size_t)(row0 + fr) * PLD + h * 128 + 8 * fq;
    const int cch = u & 31, bhh = u >> 5;
    const bf16_t* sbase = (cch == 0 ? (const bf16_t*)(ws + OFF_SMETAB) + (size_t)h * 32768 : (const bf16_t*)(ws + OFF_SPREV) + (size_t)(bhh * 31 + cch - 1) * 32768) + (size_t)(wave * 32 + fr) * 128 + 8 * fq;
    bf16x8 nf[4][2], mf[4][4]; u32x2 rr[4][2]; f32x4 nw[2];
#pragma unroll
    for (int kk = 0; kk < 4; ++kk) {
#pragma unroll
        for (int dd = 0; dd < 2; ++dd) nf[kk][dd] = __builtin_nontemporal_load((const bf16x8*)(sbase + dd * 16 * 128 + kk * 32));
#pragma unroll
        for (int tt = 0; tt < 4; ++tt) mf[kk][tt] = *(const bf16x8*)(qbase + (size_t)tt * 16 * PLD + kk * 32); }
#pragma unroll
    for (int tt = 0; tt < 4; ++tt)
#pragma unroll
        for (int dd = 0; dd < 2; ++dd) { const u32x2 w = __builtin_nontemporal_load(dump + (tt * 2 + dd) * 64); o[tt][dd] = (f32x4){__uint_as_float(w.x << 16), __uint_as_float(w.x & 0xffff0000u), __uint_as_float(w.y << 16), __uint_as_float(w.y & 0xffff0000u)}; }
#pragma unroll
    for (int tt = 0; tt < 4; ++tt)
#pragma unroll
        for (int dd = 0; dd < 2; ++dd) rr[tt][dd] = __builtin_nontemporal_load((const u32x2*)(proj + (size_t)(row0 + tt * 16 + fr) * PLD + 2048 + h * 256 + wave * 32 + dd * 16 + 4 * fq));
#pragma unroll
    for (int dd = 0; dd < 2; ++dd) nw[dd] = *(const f32x4*)(p.gla_norm_w + wave * 32 + dd * 16 + 4 * fq);
#pragma unroll
    for (int kk = 0; kk < 4; ++kk)
#pragma unroll
        for (int tt = 0; tt < 4; ++tt) { o[tt][0] = mfma16(nf[kk][0], mf[kk][tt], o[tt][0]); o[tt][1] = mfma16(nf[kk][1], mf[kk][tt], o[tt][1]); }
    float* ssq = (float*)lds;
#pragma unroll
    for (int tt = 0; tt < 4; ++tt) { float s = 0.f;
#pragma unroll
        for (int dd = 0; dd < 2; ++dd) s += (o[tt][dd][0] * o[tt][dd][0] + o[tt][dd][1] * o[tt][dd][1]) + (o[tt][dd][2] * o[tt][dd][2] + o[tt][dd][3] * o[tt][dd][3]);
        s += __shfl_xor(s, 16); s += __shfl_xor(s, 32);
        if (fq == 0) ssq[(tt * 16 + fr) * 8 + wave] = s; }
    lds_barrier();
    bf16_t* mixed = (bf16_t*)(ws + OFF_MIXED);
#pragma unroll
    for (int tt = 0; tt < 4; ++tt) { const int t = tt * 16 + fr;
        const f32x4 a = *(const f32x4*)(ssq + t * 8), b = *(const f32x4*)(ssq + t * 8 + 4);
        const float tot = ((a[0] + a[1]) + (a[2] + a[3])) + ((b[0] + b[1]) + (b[2] + b[3]));
        const float rstd = 1.0f / sqrtf(tot * (1.0f / 256.0f) + EPS);
#pragma unroll
        for (int dd = 0; dd < 2; ++dd) { const int dv = wave * 32 + dd * 16 + 4 * fq;
            const u32x2 rv = rr[tt][dd];
            float r[4] = {__uint_as_float(rv.x << 16), __uint_as_float(rv.x & 0xffff0000u), __uint_as_float(rv.y << 16), __uint_as_float(rv.y & 0xffff0000u)};
            float y[4];
#pragma unroll
            for (int j = 0; j < 4; ++j) y[j] = o[tt][dd][j] * rstd * nw[dd][j] * (r[j] / (1.0f + __expf(-r[j])));
            u32x2 w; w.x = cvt_pk_bf16(y[0], y[1]); w.y = cvt_pk_bf16(y[2], y[3]);
            *(u32x2*)(mixed + (size_t)(row0 + t) * DM + h * 256 + dv) = w; } }
    lds_barrier();
}

__device__ __forceinline__ void phase6(const Params& p) {
    const int tid = opaque_tid(), lane = tid & 63, wave = tid >> 6, gw = blockIdx.x * 8 + wave;
    const float* ssp = (const float*)(p.ws + OFF_SS3P);
    f32x4 fw[8];
#pragma unroll
    for (int j = 0; j < 8; ++j) fw[j] = ((const f32x4*)p.final_norm_w)[lane + 64 * j];
    for (int m = gw; m < MR; m += NBLK * 8) {
        const f32x4 p0 = *(const f32x4*)(ssp + (size_t)m * 8), p1 = *(const f32x4*)(ssp + (size_t)m * 8 + 4);
        const float ss = ((p0[0] + p0[1]) + (p0[2] + p0[3])) + ((p1[0] + p1[1]) + (p1[2] + p1[3]));
        const float rstd = 1.0f / sqrtf(ss * (1.0f / DM) + EPS);
        f32x4* row = (f32x4*)(p.out + (size_t)m * DM) + lane;
#pragma unroll
        for (int j = 0; j < 8; ++j) { f32x4 v = row[64 * j]; row[64 * j] = v * rstd * fw[j]; }
    }
}

__global__ void __launch_bounds__(NTHR, 2) hybrid_fwd(Params p) {
    extern __shared__ __attribute__((aligned(16))) unsigned char lds[];
    cg::grid_group grid = cg::this_grid();
    LAS unsigned char* ldsl = (LAS unsigned char*)lds;
    unsigned char* ws = p.ws;
    const int bx = blockIdx.x;
    const int xl = bx & 7, rk = bx >> 3;
    const int uA = (xl >> 1) * 128 + (2 * (rk >> 4)) * 32 + 16 * (xl & 1) + (rk & 15), uB = uA + 32;
    const int ptask = (xl >> 1) * 64 + (xl & 1) * 32 + rk;
    const int ptask_lo = (((bx - 4) & 7) >> 1) * 64 + (((bx - 4) & 7) & 1) * 32 + ((bx - 4) >> 3);

    volatile LAS unsigned* xst = (volatile LAS unsigned*)(ldsl + LDS_BYTES - 16);
    if (threadIdx.x < 4) xst[threadIdx.x] = 0u;
    unsigned* barw = (unsigned*)(ws + OFF_BAR);
    __syncthreads();
    XcdBarrier xb = xcd_barrier_post(barw, xst);
    if (p.stop == 0x7fffffff) grid.sync();

    phase0(p, lds);
    GSYNC();
#pragma unroll 1
    for (int _q = 1; _q < REP_P0; ++_q) { phase0(p, lds); GSYNC(); }

#pragma unroll 1
    for (int _q = 0; _q < REP_P1; ++_q) {
    phase1_skinny(p, lds);
    __syncthreads();
    {
        pg8::Gemm g{(const bf16_t*)(ws + OFF_XB), (const bf16_t*)(ws + OFF_WINT), MR, NPROJ, DM, XLD, XLD};
        pg8::StaticOrder S; S.init(MR, NPROJ, NBLK, bx);
        pg8::EpiBf16Scale E{(bf16_t*)(ws + OFF_PROJ), PLD, nullptr};
        pg8::gemm_phase<pg8::EpiBf16Scale>(ldsl, g, S, E);
    }
    GSYNC();
    }
    STOP_AT(1);

#if PROBE_STOP
    if (p.pad) { const int var = p.pad; GlaIn ra;
        if (!(var & 8)) { if (bx < 4 && !(var & 2)) { gla_a_load(p, 512 + bx, ra); gla_a_compute(p, lds, 512 + bx, ra); }
            gla_a_load(p, bx, ra); gla_a_compute(p, lds, bx, ra);
            if (!(var & 4)) { gla_a_load(p, bx + NBLK, ra); gla_a_compute(p, lds, bx + NBLK, ra); } }
        if (!(var & 1)) { if (bx >= 4) pool_y_task(p, bx); if (bx >= 4 && bx < 8) pool_y_task(p, bx - 4); }
    } else
#endif
    {
    {
        GlaIn ra, rb;
        if (bx < 4) { gla_a_load(p, 512 + bx, ra); gla_a_load(p, uA, rb); gla_a_compute(p, lds, 512 + bx, ra); gla_a_load(p, uB, ra); gla_a_compute(p, lds, uA, rb); gla_a_compute(p, lds, uB, ra); }
        else { gla_a_load(p, uA, ra); gla_a_load(p, uB, rb); gla_a_compute(p, lds, uA, ra); gla_a_compute(p, lds, uB, rb); }
    }
    if (bx >= 4) pool_y_task(p, ptask);
    if (bx >= 4 && bx < 8) pool_y_task(p, ptask_lo);
    }
    GSYNC();
    STOP_AT(2);

#pragma unroll 1
    for (int _q = 0; _q < REP_P2BC; ++_q) {
    if (bx < 128 && _q == 0) {
        const int gq = bx >> 5;
        pg8::Gemm g{(const bf16_t*)(ws + OFF_MIXED) + gq * 256, (const bf16_t*)(ws + OFF_POOLWT) + (size_t)gq * 65536, MR, 256, 256, DM, 256};
        pg8::StaticOrder S; S.init(MR, 256, 32, bx & 31);
        pg8::EpiBf16Scale E{(bf16_t*)(ws + OFF_MIXED) + 1024 + gq * 256, DM, p.pool_scale + gq * 256};
        pg8::gemm_phase<pg8::EpiBf16Scale>(ldsl, g, S, E);
    } else {
        const int li = ((bx >> 3) - 16) * 2 + (bx & 1);
        const int e0 = ((bx & 7) >> 1) * 32768 + li * NTHR + opaque_tid();
        gla_scan(p, e0);
        gla_scan(p, e0 + 16384);
    }
    GSYNC();
    STOP_AT(3);

    gla_c_unit(p, lds, uA); gla_c_unit(p, lds, uB);
    GSYNC();
    }
    STOP_AT(4);

#pragma unroll 1
    for (int _q = 0; _q < REP_P3; ++_q) {
    {
        pg8::Gemm g{(const bf16_t*)(ws + OFF_MIXED), (const bf16_t*)(ws + OFF_WOUTT), MR, DM, DM, DM, DM};
        pg8::StaticOrder S; S.init(MR, DM, NBLK, bx);
        pg8::EpiResid E{p.x, nullptr, (bf16_t*)(ws + OFF_H2B), DM, (float*)(ws + OFF_SS2P)};
        pg8::gemm_phase<pg8::EpiResid>(ldsl, g, S, E);
    }
    GSYNC();
    }
    STOP_AT(5);

#pragma unroll 1
    for (int _q = 0; _q < REP_P4; ++_q) {
    {
        pg8::Gemm g{(const bf16_t*)(ws + OFF_H2B), (const bf16_t*)(ws + OFF_W1T), MR, DFF, DM, DM, DM};
        pg8::StaticOrder S; S.init(MR, DFF, NBLK, bx);
        LAS float* rl = (LAS float*)(ldsl + pg8::STAGE_BYTES);
        { const int t = opaque_tid(); const float* ssp = (const float*)(ws + OFF_SS2P);
#pragma unroll 1
          for (int i = 0; i < 4; ++i) { pg8::Unit uu; if (!S.next(i, uu)) break;
              if (t < 256) { const size_t row = (size_t)uu.pm * 256 + t; const f32x4 p0 = *(const f32x4*)(ssp + row * 8), p1 = *(const f32x4*)(ssp + row * 8 + 4);
                  rl[i * 256 + t] = 1.0f / sqrtf((((p0[0] + p0[1]) + (p0[2] + p0[3])) + ((p1[0] + p1[1]) + (p1[2] + p1[3]))) * (1.0f / DM) + EPS); } }
          __syncthreads(); }
        pg8::EpiSqRelu E{(bf16_t*)(ws + OFF_ACT), DFF, rl};
        pg8::gemm_phase<pg8::EpiSqRelu>(ldsl, g, S, E);
    }
    GSYNC();
    }
    STOP_AT(6);

    {
        pg8::Gemm g{(const bf16_t*)(ws + OFF_ACT), (const bf16_t*)(ws + OFF_W2T), MR, DM, DFF, DFF, DFF};
        pg8::StaticOrder S; S.init(MR, DM, NBLK, bx);
        pg8::EpiFinal E{p.out, DM, (float*)(ws + OFF_SS3P), (unsigned*)(ws + OFF_PCNT), p.final_norm_w, (const bf16_t*)(ws + OFF_H2B)};
        pg8::gemm_phase<pg8::EpiFinal>(ldsl, g, S, E);
    }
}

extern "C" void kernel_launch(void* const* d_in, const int* in_sizes, int n_in, void* d_out, int out_size, void* d_ws, size_t ws_size, hipStream_t stream) {
    static int ready = 0;
    if (!ready) {
        if (n_in != 14 || out_size != MR * DM || ws_size < WS_NEED) { fprintf(stderr, "kernel_launch: unexpected shapes (n_in %d, out %d, ws %zu)\n", n_in, out_size, ws_size); ready = -1; return; }
        if (hipFuncSetAttribute((const void*)hybrid_fwd, hipFuncAttributeMaxDynamicSharedMemorySize, LDS_BYTES) != hipSuccess) { fprintf(stderr, "kernel_launch: hipFuncSetAttribute failed\n"); ready = -1; return; }
        ready = 1;
    }
    if (ready < 0) return;
    Params p{};
    p.x = (const float*)d_in[0]; p.meta = (const float*)d_in[1]; p.norm1_w = (const float*)d_in[2]; p.w_in = (const float*)d_in[3];
    p.gate_w2 = (const float*)d_in[4]; p.gate_b = (const float*)d_in[5]; p.gla_norm_w = (const float*)d_in[6]; p.pool_w = (const float*)d_in[7];
    p.pool_scale = (const float*)d_in[8]; p.w_out = (const float*)d_in[9]; p.norm2_w = (const float*)d_in[10]; p.mlp_w1 = (const float*)d_in[11];
    p.mlp_w2 = (const float*)d_in[12]; p.final_norm_w = (const float*)d_in[13];
    p.out = (float*)d_out; p.ws = (unsigned char*)d_ws;
    p.stop = 99; p.pad = 0;
    if (hipMemsetAsync((unsigned char*)d_ws + OFF_BAR, 0, 16384 + 32 * 256, stream) != hipSuccess) { fprintf(stderr, "kernel_launch: memset failed\n"); return; }
#if PROBE_STOP
    { Params q = p; q.stop = PROBE_STOP; q.pad = PROBE_VAR; void* qa[] = {&q}; (void)hipLaunchCooperativeKernel((void*)hybrid_fwd, dim3(NBLK), dim3(NTHR), qa, LDS_BYTES, stream);
      (void)hipMemsetAsync((unsigned char*)d_ws + OFF_BAR, 0, 16384 + 32 * 256, stream); }
#endif
    void* args[] = {&p};
    hipError_t e = hipLaunchCooperativeKernel((void*)hybrid_fwd, dim3(NBLK), dim3(NTHR), args, LDS_BYTES, stream);
    if (e != hipSuccess) fprintf(stderr, "kernel_launch: cooperative launch failed: %s\n", hipGetErrorString(e));
}
```
